# Optimizing an MI355X kernel written in HIP

```python
import math
import jax, jax.numpy as jnp
from jax import lax
import numpy as np

D_MODEL = 1024
BATCH = 4
SEQ = 4096
DEPTH = 2

HEAD_DIM = 64
N_SB_HEADS = 8
N_MOBA_HEADS = 8
N_ATT_HEADS = N_SB_HEADS + N_MOBA_HEADS
ATT_W = N_ATT_HEADS * HEAD_DIM
SB_QBLOCK = 128
MOBA_BLOCK = 256
MOBA_TOPK = 3
MOBA_QBLOCK = 32
N_RET_HEADS = 4
RET_DK = D_MODEL // N_RET_HEADS
RET_DV = 2 * RET_DK
RET_QK_W = N_RET_HEADS * RET_DK
RET_V_W = N_RET_HEADS * RET_DV
RET_CHUNK = 128
D_FF = -(-8 * D_MODEL // 768) * 256
ROPE_THETA = 10000.0
NORM_EPS = 1e-6
GN_EPS = 1e-5
NEG = -1e30
N_EVEN = (DEPTH + 1) // 2
N_ODD = DEPTH // 2

kernel_name = "hybrid_stickbreak_moba_retention_adaln"


def rms_norm(x, g):
    xf = x.astype(jnp.float32)
    y = xf * lax.rsqrt(jnp.mean(xf * xf, axis=-1, keepdims=True) + NORM_EPS)
    return (y * g.astype(jnp.float32)).astype(x.dtype)


def rotary(x, pos):
    d = x.shape[-1]
    inv = ROPE_THETA ** (-jnp.arange(0, d, 2, dtype=jnp.float32) / d)
    ang = pos.astype(jnp.float32)[:, None] * inv[None, :]
    cos, sin = jnp.cos(ang), jnp.sin(ang)
    xf = x.astype(jnp.float32)
    x1, x2 = xf[..., : d // 2], xf[..., d // 2:]
    out = jnp.concatenate([x1 * cos - x2 * sin, x2 * cos + x1 * sin], axis=-1)
    return out.astype(x.dtype)


def ada_mod(c, w, b):
    m = jax.nn.silu(c) @ w + b
    return jnp.split(m[:, None, :], 6, axis=-1)


def modulate(h, shift, scale):
    return h * (1 + scale) + shift


def stick_breaking_attention(q, k, v):
    B, H, S, D = q.shape
    nblk = S // SB_QBLOCK
    kpos = jnp.arange(S)
    scale = D ** -0.5

    def block(i):
        start = i * SB_QBLOCK
        qb = lax.dynamic_slice_in_dim(q, start, SB_QBLOCK, axis=2)
        z = jnp.einsum('bhqd,bhkd->bhqk', qb, k).astype(jnp.float32) * scale
        qpos = start + jnp.arange(SB_QBLOCK)
        strict = kpos[None, :] < qpos[:, None]
        log_1mb = jnp.where(strict, jax.nn.log_sigmoid(-z), 0.0)
        after = lax.cumsum(log_1mb, axis=3, reverse=True) - log_1mb
        a = jnp.where(strict, jnp.exp(jax.nn.log_sigmoid(z) + after), 0.0)
        return jnp.einsum('bhqk,bhkd->bhqd', a.astype(v.dtype), v)

    out = lax.map(block, jnp.arange(nblk))
    return jnp.moveaxis(out, 0, 2).reshape(B, H, S, D)


def moba_attention(q, k, v):
    B, H, S, D = q.shape
    nb = -(-S // MOBA_BLOCK)
    spad = nb * MOBA_BLOCK
    pad = ((0, 0), (0, 0), (0, spad - S), (0, 0))
    kp = jnp.pad(k, pad)
    vp = jnp.pad(v, pad)
    kb = kp.reshape(B, H, nb, MOBA_BLOCK, D)
    vb = vp.reshape(B, H, nb, MOBA_BLOCK, D)
    kmean = jnp.mean(kb.astype(jnp.float32), axis=3).astype(k.dtype)
    kk = min(MOBA_TOPK, nb)
    scale = D ** -0.5
    nqb = S // MOBA_QBLOCK
    bi = jnp.arange(B)[:, None, None, None]
    hi = jnp.arange(H)[None, :, None, None]
    blk_ids = jnp.arange(nb)
    kpos_in = jnp.arange(MOBA_BLOCK)

    def block(i):
        start = i * MOBA_QBLOCK
        qb = lax.dynamic_slice_in_dim(q, start, MOBA_QBLOCK, axis=2)
        qpos = start + jnp.arange(MOBA_QBLOCK)
        own = start // MOBA_BLOCK
        gate = jnp.einsum('bhqd,bhnd->bhqn', qb, kmean).astype(jnp.float32)
        gate = jnp.where(blk_ids < own, gate, NEG)
        _, idx = lax.top_k(gate, kk)
        sel_valid = idx < own
        ksel = kb[bi, hi, idx]
        vsel = vb[bi, hi, idx]
        s_past = jnp.einsum('bhqd,bhqnkd->bhqnk', qb, ksel).astype(jnp.float32) * scale
        s_past = jnp.where(sel_valid[..., None], s_past, NEG)
        s_past = s_past.reshape(B, H, MOBA_QBLOCK, kk * MOBA_BLOCK)
        k_own = lax.dynamic_slice_in_dim(kp, own * MOBA_BLOCK, MOBA_BLOCK, axis=2)
        v_own = lax.dynamic_slice_in_dim(vp, own * MOBA_BLOCK, MOBA_BLOCK, axis=2)
        s_own = jnp.einsum('bhqd,bhkd->bhqk', qb, k_own).astype(jnp.float32) * scale
        kpos_own = own * MOBA_BLOCK + kpos_in
        s_own = jnp.where(kpos_own[None, :] <= qpos[:, None], s_own, NEG)
        p = jax.nn.softmax(jnp.concatenate([s_past, s_own], axis=-1), axis=-1).astype(v.dtype)
        p_past = p[..., : kk * MOBA_BLOCK].reshape(B, H, MOBA_QBLOCK, kk, MOBA_BLOCK)
        p_own = p[..., kk * MOBA_BLOCK:]
        return (jnp.einsum('bhqnk,bhqnkd->bhqd', p_past, vsel)
                + jnp.einsum('bhqk,bhkd->bhqd', p_own, v_own))

    out = lax.map(block, jnp.arange(nqb))
    return jnp.moveaxis(out, 0, 2).reshape(B, H, S, D)


def retention_chunkwise(q, k, v):
    B, H, S, dk = q.shape
    dv = v.shape[-1]
    C = RET_CHUNK
    nc = S // C
    log_g = jnp.log(1.0 - 2.0 ** (-5.0 - jnp.arange(H, dtype=jnp.float32)))
    n = jnp.arange(C, dtype=jnp.float32)
    diff = n[:, None] - n[None, :]
    decay = jnp.where(diff >= 0, jnp.exp(log_g[:, None, None] * jnp.maximum(diff, 0.0)), 0.0)
    xi = jnp.exp(log_g[:, None] * (n + 1.0))
    zeta = jnp.exp(log_g[:, None] * (C - 1.0 - n))
    chunk_decay = jnp.exp(log_g * C)

    def chunks(t):
        return jnp.moveaxis(t.reshape(B, H, nc, C, t.shape[-1]), 2, 0)

    def step(state, inp):
        qi, ki, vi = inp
        inner = jnp.einsum('bhqd,bhkd->bhqk', qi, ki).astype(jnp.float32) * decay
        o = (jnp.einsum('bhqk,bhkv->bhqv', inner, vi.astype(jnp.float32))
             + jnp.einsum('bhqd,bhdv->bhqv', qi.astype(jnp.float32), state) * xi[..., None])
        state = state * chunk_decay[:, None, None] + jnp.einsum(
            'bhkd,bhkv->bhdv', ki.astype(jnp.float32) * zeta[..., None], vi.astype(jnp.float32))
        return state, o

    init = jnp.zeros((B, H, dk, dv), jnp.float32)
    _, out = lax.scan(step, init, (chunks(q), chunks(k), chunks(v)))
    return jnp.moveaxis(out, 0, 2).reshape(B, H, S, dv)


def attn_hybrid_mixer(h, w_qkv, w_o, pos):
    B, S, _ = h.shape
    qkv = (h @ w_qkv).reshape(B, S, 3, N_ATT_HEADS, HEAD_DIM).transpose(2, 0, 3, 1, 4)
    q, k, v = qkv[0], qkv[1], qkv[2]
    sb = stick_breaking_attention(q[:, :N_SB_HEADS], k[:, :N_SB_HEADS], v[:, :N_SB_HEADS])
    qm = rotary(q[:, N_SB_HEADS:], pos)
    km = rotary(k[:, N_SB_HEADS:], pos)
    mb = moba_attention(qm, km, v[:, N_SB_HEADS:])
    o = jnp.concatenate([sb, mb], axis=1).transpose(0, 2, 1, 3).reshape(B, S, ATT_W)
    return o @ w_o


def retention_mixer(h, w_in, gn_gain, w_o, pos):
    B, S, _ = h.shape
    proj = h @ w_in
    q, k, v, g = jnp.split(proj, [RET_QK_W, 2 * RET_QK_W, 2 * RET_QK_W + RET_V_W], axis=-1)

    def heads(t, d):
        return t.reshape(B, S, N_RET_HEADS, d).transpose(0, 2, 1, 3)

    q = rotary(heads(q, RET_DK), pos)
    k = rotary(heads(k, RET_DK), pos) * (RET_DK ** -0.5)
    v = heads(v, RET_DV)
    o = retention_chunkwise(q, k, v)
    mu = jnp.mean(o, axis=-1, keepdims=True)
    var = jnp.mean(jnp.square(o - mu), axis=-1, keepdims=True)
    o = (o - mu) * lax.rsqrt(var + GN_EPS)
    o = o.transpose(0, 2, 1, 3).reshape(B, S, RET_V_W) * gn_gain.astype(jnp.float32)
    return (jax.nn.silu(g) * o.astype(h.dtype)) @ w_o


def swiglu(h, w_gate_up, w_down):
    gt, up = jnp.split(h @ w_gate_up, 2, axis=-1)
    return (jax.nn.silu(gt) * up) @ w_down


def setup_inputs(seed: int = 0) -> dict:
    key = jax.random.key(seed)
    ks = jax.random.split(key, 14)
    f32 = jnp.float32

    def nrm(k, shape, fan_in):
        return jax.random.normal(k, shape, f32) * (fan_in ** -0.5)

    return {
        "x": jax.random.normal(ks[0], (BATCH, SEQ, D_MODEL), f32),
        "c": jax.random.normal(ks[1], (BATCH, D_MODEL), f32),
        "ada_w": nrm(ks[2], (DEPTH, D_MODEL, 6 * D_MODEL), D_MODEL),
        "ada_b": 0.02 * jax.random.normal(ks[3], (DEPTH, 6 * D_MODEL), f32),
        "norm_gains": 1.0 + 0.05 * jax.random.normal(ks[4], (DEPTH, 2, D_MODEL), f32),
        "att_w_qkv": nrm(ks[5], (N_EVEN, D_MODEL, 3 * ATT_W), D_MODEL),
        "att_w_o": nrm(ks[6], (N_EVEN, ATT_W, D_MODEL), ATT_W),
        "ret_w_in": nrm(ks[7], (N_ODD, D_MODEL, 2 * RET_QK_W + 2 * RET_V_W), D_MODEL),
        "ret_gn": 1.0 + 0.05 * jax.random.normal(ks[8], (N_ODD, RET_V_W), f32),
        "ret_w_o": nrm(ks[9], (N_ODD, RET_V_W, D_MODEL), RET_V_W),
        "ffn_w_gate_up": nrm(ks[10], (DEPTH, D_MODEL, 2 * D_FF), D_MODEL),
        "ffn_w_down": nrm(ks[11], (DEPTH, D_FF, D_MODEL), D_FF),
        "final_norm": 1.0 + 0.05 * jax.random.normal(ks[12], (D_MODEL,), f32),
    }


def reference(x, c, ada_w, ada_b, norm_gains, att_w_qkv, att_w_o, ret_w_in, ret_gn,
              ret_w_o, ffn_w_gate_up, ffn_w_down, final_norm):
    S = x.shape[1]
    pos = jnp.arange(S, dtype=jnp.int32)
    for layer in range(DEPTH):
        shift_m, scale_m, gate_m, shift_f, scale_f, gate_f = ada_mod(c, ada_w[layer], ada_b[layer])
        h = modulate(rms_norm(x, norm_gains[layer, 0]), shift_m, scale_m)
        j = layer // 2
        if layer % 2 == 0:
            y = attn_hybrid_mixer(h, att_w_qkv[j], att_w_o[j], pos)
        else:
            y = retention_mixer(h, ret_w_in[j], ret_gn[j], ret_w_o[j], pos)
        x = x + gate_m * y
        h = modulate(rms_norm(x, norm_gains[layer, 1]), shift_f, scale_f)
        x = x + gate_f * swiglu(h, ffn_w_gate_up[layer], ffn_w_down[layer])
    return rms_norm(x, final_norm)
```

```cpp
#include <hip/hip_runtime.h>
#include <cstdio>
#include <cstdint>
#include <cmath>
__device__ const double INV64[32] = {
1, 0.74989420933245587, 0.56234132519034907, 0.42169650342858223,
0.31622776601683794, 0.23713737056616552, 0.17782794100389229, 0.1333521432163324,
0.10000000000000001, 0.074989420933245579, 0.056234132519034911, 0.042169650342858224,
0.031622776601683791, 0.023713737056616554, 0.017782794100389229, 0.013335214321633241,
0.01, 0.0074989420933245579, 0.005623413251903491, 0.0042169650342858229,
0.0031622776601683794, 0.0023713737056616554, 0.0017782794100389228, 0.0013335214321633241,
0.001, 0.00074989420933245586, 0.0005623413251903491, 0.00042169650342858224,
0.00031622776601683794, 0.00023713737056616554, 0.00017782794100389227, 0.0001333521432163324,
};
__device__ const double INV256[128] = {
1, 0.93057204092969903, 0.86596432336006535, 0.80584218776148187,
0.74989420933245587, 0.69783058485986638, 0.64938163157621132, 0.60429639023813286,
0.56234132519034907, 0.5232991146814947, 0.48696752516586311, 0.45315836376008178,
0.42169650342858223, 0.39241897584845359, 0.36517412725483772, 0.33982083289425596,
0.31622776601683794, 0.29427271762092816, 0.27384196342643613, 0.25482967479793467,
0.23713737056616552, 0.22067340690845899, 0.20535250264571461, 0.19109529749704404,
0.17782794100389229, 0.16548170999431813, 0.15399265260594919, 0.14330125702369628,
0.1333521432163324, 0.12409377607517195, 0.11547819846894582, 0.10746078283213174,
0.10000000000000001, 0.0930572040929699, 0.086596432336006529, 0.080584218776148187,
0.074989420933245579, 0.069783058485986635, 0.064938163157621132, 0.060429639023813285,
0.056234132519034911, 0.05232991146814947, 0.048696752516586311, 0.045315836376008181,
0.042169650342858224, 0.039241897584845357, 0.036517412725483769, 0.033982083289425591,
0.031622776601683791, 0.029427271762092817, 0.027384196342643614, 0.025482967479793464,
0.023713737056616554, 0.022067340690845899, 0.02053525026457146, 0.019109529749704406,
0.017782794100389229, 0.016548170999431813, 0.015399265260594919, 0.014330125702369627,
0.013335214321633241, 0.012409377607517195, 0.011547819846894581, 0.010746078283213174,
0.01, 0.0093057204092969904, 0.0086596432336006543, 0.008058421877614819,
0.0074989420933245579, 0.0069783058485986633, 0.006493816315762113, 0.0060429639023813278,
0.005623413251903491, 0.0052329911468149467, 0.004869675251658631, 0.0045315836376008181,
0.0042169650342858229, 0.0039241897584845363, 0.0036517412725483771, 0.0033982083289425592,
0.0031622776601683794, 0.002942727176209282, 0.0027384196342643613, 0.0025482967479793467,
0.0023713737056616554, 0.0022067340690845897, 0.002053525026457146, 0.0019109529749704406,
0.0017782794100389228, 0.0016548170999431814, 0.001539926526059492, 0.0014330125702369627,
0.0013335214321633241, 0.0012409377607517195, 0.0011547819846894581, 0.0010746078283213176,
0.001, 0.00093057204092969893, 0.00086596432336006539, 0.00080584218776148179,
0.00074989420933245586, 0.00069783058485986635, 0.00064938163157621134, 0.00060429639023813287,
0.0005623413251903491, 0.00052329911468149473, 0.0004869675251658631, 0.00045315836376008179,
0.00042169650342858224, 0.00039241897584845359, 0.0003651741272548377, 0.00033982083289425596,
0.00031622776601683794, 0.00029427271762092817, 0.00027384196342643611, 0.00025482967479793463,
0.00023713737056616554, 0.00022067340690845897, 0.00020535250264571461, 0.00019109529749704405,
0.00017782794100389227, 0.00016548170999431815, 0.00015399265260594919, 0.00014330125702369627,
0.0001333521432163324, 0.00012409377607517196, 0.00011547819846894582, 0.00010746078283213175,
};
namespace pg8 {
#define PG8_LAS __attribute__((address_space(3)))
typedef unsigned short bf16_t;
typedef short bf16x8 __attribute__((ext_vector_type(8)));
typedef float f32x4 __attribute__((ext_vector_type(4)));
typedef unsigned u32x4 __attribute__((ext_vector_type(4)));
constexpr int BM = 256, BK = 64, HALF = 128, HTB = HALF * BK * 2  , STAGE_BYTES = 8 * HTB, NXCD = 8, WGM = 8;

__host__ __device__ __forceinline__ int lds_byte(int r, int c) { const int st = (r >> 4) * 2 + (c >> 5), rr = r & 15, cc = c & 31, ob = rr * 64 + cc * 2; return st * 1024 + (ob ^ (((ob >> 9) & 1) << 5)); }
__host__ __device__ __forceinline__ void stage_rc(int b, int& R, int& C) { const int st = b / 1024, sb = b % 1024, swz = sb ^ (((sb >> 9) & 1) << 5); R = (st >> 1) * 16 + swz / 64; C = (st & 1) * 32 + (swz % 64) / 2; }
__host__ __device__ __forceinline__ int perm32(int rho) { const int n = rho >> 4, i = rho & 15; return 8 * (i >> 2) + 4 * n + (i & 3); }

struct Unit { int pm, pn; };
struct Gemm { const bf16_t* A; const bf16_t* Bt; int M, N, K; };

struct StaticOrder {
    int nM, nN, nwg, G, c;
    __host__ __device__ void init(int M, int N, int G_, int c_) { nM = M / BM; nN = N / BM; nwg = nM * nN; G = G_; c = c_; }
    __host__ __device__ bool next(int i, Unit& u) const {
        const long L = (long)i * G + c; if (L >= nwg) return false;
        int wgid = (int)L; { const int q = nwg / NXCD, r = nwg % NXCD, xcd = wgid % NXCD, off = wgid / NXCD; wgid = (xcd < r ? xcd * (q + 1) : r * (q + 1) + (xcd - r) * q) + off; }
        const int nig = WGM * nN, gid = wgid / nig, fm = gid * WGM, gsz = (nM - fm) < WGM ? (nM - fm) : WGM;
        u.pm = fm + ((wgid % nig) % gsz); u.pn = (wgid % nig) / gsz; return true;
    }
    __device__ __forceinline__ void a_ready(const Unit&) const {}
    __device__ __forceinline__ void done(const Unit&) const {}
};

__device__ __forceinline__ unsigned cvt_pk_bf16(float lo, float hi) { unsigned r; asm volatile("v_cvt_pk_bf16_f32 %0, %1, %2" : "=v"(r) : "v"(lo), "v"(hi)); return r; }
typedef float f32x2 __attribute__((ext_vector_type(2)));
__device__ __forceinline__ f32x2 gelu_pk(f32x2 v) {
    const f32x2 av = __builtin_elementwise_abs(v), d = av * 0.2316418882f + 1.0f;
    f32x2 t; t.x = __builtin_amdgcn_rcpf(d.x); t.y = __builtin_amdgcn_rcpf(d.y);
    f32x2 q = t * 0.5307027145f + (-0.7265760135f); q = q * t + 0.7107068705f; q = q * t + (-0.142248368f); q = q * t + 0.127414796f; q = q * t;
    const f32x2 s = (v * v) * (-0.72134752044f);
    f32x2 e; e.x = __builtin_amdgcn_exp2f(s.x); e.y = __builtin_amdgcn_exp2f(s.y);
    const f32x2 m = v * (q * e), r = v - m;
    f32x2 o; o.x = v.x < 0.f ? m.x : r.x; o.y = v.y < 0.f ? m.y : r.y; return o;
}

template <int ACT  > struct EpiBf16 {
    static constexpr bool PERM = true, AFTER_DRAIN = false; static_assert(ACT == 0 || ACT == 1, "EpiBf16: ACT is 0 (none) or 1 (gelu_pk)");
    bf16_t* O; int ldc; const float* bias; int split_cols; size_t split_stride; float scale0;
    __device__ __forceinline__ void operator()(const f32x4 (&acc)[2][2][4][2], const Unit& u, int wr, int wc, int fr, int fq) const {
        const int row0 = u.pm * BM + wr * 64 + fr; int colt = u.pn * BM; bf16_t* base = O;
        float sc = 1.f; if (split_cols) { const int t = colt / split_cols; base += (size_t)t * split_stride; colt -= t * split_cols; if (t == 0) sc = scale0; }
        const int col0 = colt + wc * 32 + 8 * fq, bcol0 = u.pn * BM + wc * 32 + 8 * fq;
        f32x4 bv[2][2];
#pragma unroll
        for (int bj = 0; bj < 2; ++bj)
#pragma unroll
            for (int n = 0; n < 2; ++n) bv[bj][n] = bias ? *(const f32x4*)(bias + bcol0 + bj * HALF + 4 * n) : (f32x4){0.f, 0.f, 0.f, 0.f};
#pragma unroll
        for (int ai = 0; ai < 2; ++ai)
#pragma unroll
            for (int m = 0; m < 4; ++m) { bf16_t* rowp = base + (size_t)(row0 + ai * HALF + m * 16) * ldc + col0;
#pragma unroll
                for (int bj = 0; bj < 2; ++bj) { f32x4 v0 = acc[ai][bj][m][0] + bv[bj][0], v1 = acc[ai][bj][m][1] + bv[bj][1];
                    if (ACT == 1) { f32x2 a = gelu_pk((f32x2){v0[0], v0[1]}), b = gelu_pk((f32x2){v0[2], v0[3]}), c = gelu_pk((f32x2){v1[0], v1[1]}), d = gelu_pk((f32x2){v1[2], v1[3]});
                        v0 = (f32x4){a.x, a.y, b.x, b.y}; v1 = (f32x4){c.x, c.y, d.x, d.y}; }
                    v0 = v0 * sc; v1 = v1 * sc; u32x4 w; w.x = cvt_pk_bf16(v0[0], v0[1]); w.y = cvt_pk_bf16(v0[2], v0[3]); w.z = cvt_pk_bf16(v1[0], v1[1]); w.w = cvt_pk_bf16(v1[2], v1[3]);
                    *(u32x4*)(rowp + bj * HALF) = w; } }
    }
};

struct PanelStats {
    unsigned* xbuf;
    unsigned* cnt;
    unsigned* tmo;
    int ntn; float eps;
    unsigned code;
    __device__ __forceinline__ bool run(const f32x4 (&v)[2][2][4][2], const Unit& u, int wr, int wc, int fr, int fq, PG8_LAS unsigned char* lds, int wid, int lane) const {
        typedef float f32x2v __attribute__((ext_vector_type(2)));
        PG8_LAS f32x2v* P = (PG8_LAS f32x2v*)lds;
        PG8_LAS f32x2v* S = (PG8_LAS f32x2v*)(lds + 8192);
        PG8_LAS unsigned* flag = (PG8_LAS unsigned*)(lds + 8192 + 2048);
#pragma unroll
        for (int ai = 0; ai < 2; ++ai)
#pragma unroll
            for (int m = 0; m < 4; ++m) {
                float s = 0.f;
#pragma unroll
                for (int bj = 0; bj < 2; ++bj)
#pragma unroll
                    for (int n = 0; n < 2; ++n) { const f32x4 x = v[ai][bj][m][n]; s += (x[0] + x[1]) + (x[2] + x[3]); }
                s += __shfl_xor(s, 16); s += __shfl_xor(s, 32);
                const float mw = s * (1.0f / 64.0f); float q = 0.f;
#pragma unroll
                for (int bj = 0; bj < 2; ++bj)
#pragma unroll
                    for (int n = 0; n < 2; ++n) { const f32x4 d = v[ai][bj][m][n] - mw; q += (d[0] * d[0] + d[1] * d[1]) + (d[2] * d[2] + d[3] * d[3]); }
                q += __shfl_xor(q, 16); q += __shfl_xor(q, 32);
                if (fq == 0) P[(ai * HALF + wr * 64 + m * 16 + fr) * 4 + wc] = (f32x2v){mw, q};
            }
        asm volatile("s_waitcnt lgkmcnt(0)" ::: "memory"); __builtin_amdgcn_s_barrier(); asm volatile("" ::: "memory");
#if defined(BROKEN_EXCHANGE_NO_WAIT)
#warning BROKEN CONTROL BUILD: the row-statistics exchange does not wait; results are wrong by design
        if (blockIdx.x >= 64) { const long long t0_ = clock64(); while (clock64() - t0_ < 60000) __builtin_amdgcn_s_sleep(8); }
#endif
        const int row = wid * 32 + (lane & 31);
        if (lane < 32) {
            const f32x2v a = P[row * 4 + 0], b = P[row * 4 + 1], c = P[row * 4 + 2], d = P[row * 4 + 3];
            const float mt = (a.x + b.x + c.x + d.x) * 0.25f;
            const float da = a.x - mt, db = b.x - mt, dc = c.x - mt, dd = d.x - mt;
            const float m2 = (a.y + b.y) + (c.y + d.y) + 64.0f * ((da * da + db * db) + (dc * dc + dd * dd));
            unsigned long long* slot = (unsigned long long*)xbuf + ((size_t)(u.pm * BM + row) * 4 + u.pn);
            __hip_atomic_store(slot, ((unsigned long long)__float_as_uint(m2) << 32) | __float_as_uint(mt), __ATOMIC_RELAXED, __HIP_MEMORY_SCOPE_AGENT);
        }
        asm volatile("s_waitcnt vmcnt(0)" ::: "memory");
        if (lane == 0) __hip_atomic_fetch_add(cnt + 64 * u.pm, 1u, __ATOMIC_RELAXED, __HIP_MEMORY_SCOPE_AGENT);
        if (wid == 0) {
            bool dead = false; const unsigned long long t0 = __builtin_amdgcn_s_memrealtime(); const unsigned want = 8u * (unsigned)ntn;
            for (;;) {
#if defined(BROKEN_EXCHANGE_NO_WAIT)
                break;
#endif
                if ((unsigned)__builtin_amdgcn_readfirstlane(__hip_atomic_load(cnt + 64 * u.pm, __ATOMIC_RELAXED, __HIP_MEMORY_SCOPE_AGENT)) >= want) break;
                if (__builtin_amdgcn_s_memrealtime() - t0 > 2000000ull) {
                    if (lane == 0) { unsigned expect = 0u; __hip_atomic_compare_exchange_strong(tmo + 1, &expect, code | (unsigned)(u.pm & 0xff), __ATOMIC_RELAXED, __ATOMIC_RELAXED, __HIP_MEMORY_SCOPE_AGENT);
                                     __hip_atomic_store(tmo, 1u, __ATOMIC_RELAXED, __HIP_MEMORY_SCOPE_AGENT); }
                    dead = true; break; }
                __builtin_amdgcn_s_sleep(2);
            }
            __builtin_amdgcn_fence(__ATOMIC_ACQUIRE, "agent");
            if (lane == 0) flag[0] = dead ? 1u : 0u;
        }
        asm volatile("s_waitcnt vmcnt(0) lgkmcnt(0)" ::: "memory"); __builtin_amdgcn_s_barrier(); asm volatile("" ::: "memory");
        const bool bad = flag[0] != 0u;
        if (lane < 32) {
            const unsigned long long* slot = (const unsigned long long*)xbuf + (size_t)(u.pm * BM + row) * 4; float mt[4], m2[4]; float ms = 0.f;
#pragma unroll
            for (int t = 0; t < 4; ++t) { if (t < ntn) { const unsigned long long w = __hip_atomic_load(slot + t, __ATOMIC_RELAXED, __HIP_MEMORY_SCOPE_AGENT); mt[t] = __uint_as_float((unsigned)w); m2[t] = __uint_as_float((unsigned)(w >> 32)); } else { mt[t] = 0.f; m2[t] = 0.f; } ms += mt[t]; }
            const float mean = ms / (float)ntn; float q = 0.f;
#pragma unroll
            for (int t = 0; t < 4; ++t) if (t < ntn) { const float dm = mt[t] - mean; q += m2[t] + 256.0f * dm * dm; }
            S[row] = (f32x2v){mean, 1.0f / sqrtf(q / (256.0f * (float)ntn) + eps)};
        }
        asm volatile("s_waitcnt lgkmcnt(0)" ::: "memory"); __builtin_amdgcn_s_barrier(); asm volatile("" ::: "memory");
        return bad;
    }
};
struct EpiLnRes {
    static constexpr bool PERM = false, AFTER_DRAIN = true;
    const float* base; float* out; int ldc; const float* bias; PanelStats st; unsigned poison;
    __device__ __forceinline__ void fused(f32x4 (&acc)[2][2][4][2], const Unit& u, int wr, int wc, int fr, int fq, PG8_LAS unsigned char* lds, int wid, int lane) const {
        typedef float f32x2v __attribute__((ext_vector_type(2)));
        const PG8_LAS f32x2v* S = (const PG8_LAS f32x2v*)(lds + 8192);
        const int col0 = u.pn * BM + wc * 32 + 4 * fq;
#pragma unroll
        for (int bj = 0; bj < 2; ++bj)
#pragma unroll
            for (int n = 0; n < 2; ++n) { const f32x4 bv = bias ? *(const f32x4*)(bias + col0 + bj * HALF + n * 16) : (f32x4){0.f, 0.f, 0.f, 0.f};
#pragma unroll
                for (int ai = 0; ai < 2; ++ai)
#pragma unroll
                    for (int m = 0; m < 4; ++m) acc[ai][bj][m][n] += bv; }
        f32x4 pre[4][2][2];
#pragma unroll
        for (int m = 0; m < 4; ++m) { const size_t off = (size_t)(u.pm * BM + wr * 64 + m * 16 + fr) * ldc + col0;
#pragma unroll
            for (int bj = 0; bj < 2; ++bj)
#pragma unroll
                for (int n = 0; n < 2; ++n) pre[m][bj][n] = *(const f32x4*)(base + off + bj * HALF + n * 16); }
        const bool bad = st.run(acc, u, wr, wc, fr, fq, lds, wid, lane) || poison != 0u;
        const float qnan = __builtin_nanf("");
#pragma unroll
        for (int ai = 0; ai < 2; ++ai)
#pragma unroll
            for (int m = 0; m < 4; ++m) { const int r = ai * HALF + wr * 64 + m * 16 + fr; const f32x2v sr = S[r]; const size_t off = (size_t)(u.pm * BM + r) * ldc + col0;
#pragma unroll
                for (int bj = 0; bj < 2; ++bj)
#pragma unroll
                    for (int n = 0; n < 2; ++n) { const f32x4 bs = ai == 0 ? pre[m][bj][n] : *(const f32x4*)(base + off + bj * HALF + n * 16); f32x4 o = bs + (acc[ai][bj][m][n] - sr.x) * sr.y;
                        if (bad) o = (f32x4){qnan, qnan, qnan, qnan}; *(f32x4*)(out + off + bj * HALF + n * 16) = o; }
                if (m & 1) asm volatile("" ::: "memory"); }
    }
};
struct EpiLnResLn {
    static constexpr bool PERM = false, AFTER_DRAIN = true;
    const float* base; float* out; bf16_t* xn; int ldc; const float* bias; PanelStats st1, st2; unsigned poison;
    __device__ __forceinline__ void fused(f32x4 (&acc)[2][2][4][2], const Unit& u, int wr, int wc, int fr, int fq, PG8_LAS unsigned char* lds, int wid, int lane) const {
        typedef float f32x2v __attribute__((ext_vector_type(2))); typedef unsigned u32x2v __attribute__((ext_vector_type(2)));
        const PG8_LAS f32x2v* S = (const PG8_LAS f32x2v*)(lds + 8192);
        const int col0 = u.pn * BM + wc * 32 + 4 * fq;
#pragma unroll
        for (int bj = 0; bj < 2; ++bj)
#pragma unroll
            for (int n = 0; n < 2; ++n) { const f32x4 bv = bias ? *(const f32x4*)(bias + col0 + bj * HALF + n * 16) : (f32x4){0.f, 0.f, 0.f, 0.f};
#pragma unroll
                for (int ai = 0; ai < 2; ++ai)
#pragma unroll
                    for (int m = 0; m < 4; ++m) acc[ai][bj][m][n] += bv; }
        bool bad = st1.run(acc, u, wr, wc, fr, fq, lds, wid, lane) || poison != 0u;
        const float qnan = __builtin_nanf("");
#pragma unroll
        for (int ai = 0; ai < 2; ++ai)
#pragma unroll
            for (int m = 0; m < 4; ++m) { const int r = ai * HALF + wr * 64 + m * 16 + fr; const f32x2v sr = S[r]; const size_t off = (size_t)(u.pm * BM + r) * ldc + col0;
#pragma unroll
                for (int bj = 0; bj < 2; ++bj)
#pragma unroll
                    for (int n = 0; n < 2; ++n) { const f32x4 bs = *(const f32x4*)(base + off + bj * HALF + n * 16); acc[ai][bj][m][n] = bs + (acc[ai][bj][m][n] - sr.x) * sr.y; }
                asm volatile("" : "+v"(acc[ai][0][m][0]), "+v"(acc[ai][0][m][1]), "+v"(acc[ai][1][m][0]), "+v"(acc[ai][1][m][1]));
                if (m & 1) asm volatile("" ::: "memory"); }
        const bool bad1 = bad;
        bad = st2.run(acc, u, wr, wc, fr, fq, lds, wid, lane) || bad;
#pragma unroll
        for (int ai = 0; ai < 2; ++ai)
#pragma unroll
            for (int m = 0; m < 4; ++m) { const int r = ai * HALF + wr * 64 + m * 16 + fr; const f32x2v sr = S[r]; const size_t off = (size_t)(u.pm * BM + r) * ldc + col0;
#pragma unroll
                for (int bj = 0; bj < 2; ++bj)
#pragma unroll
                    for (int n = 0; n < 2; ++n) { const f32x4 x1 = acc[ai][bj][m][n]; *(f32x4*)(out + off + bj * HALF + n * 16) = bad1 ? (f32x4){qnan, qnan, qnan, qnan} : x1;
                        const f32x4 o = (x1 - sr.x) * sr.y; u32x2v w; w.x = cvt_pk_bf16(o[0], o[1]); w.y = cvt_pk_bf16(o[2], o[3]);
                        if (bad) { w.x = 0x7fc07fc0u; w.y = 0x7fc07fc0u; } *(u32x2v*)(xn + off + bj * HALF + n * 16) = w; }
                asm volatile("" ::: "memory"); }
    }
};

template <class Epi, class Sched, bool ALIGN_EPI = false, bool SP2 = false>
__device__ __forceinline__ void gemm_phase(PG8_LAS unsigned char* lds, const Gemm g, const Sched& S, const Epi& E) {
    const int tid = threadIdx.x, wid = __builtin_amdgcn_readfirstlane(tid >> 6), lane = tid & 63, wr = wid >> 2, wc = wid & 3, fr = lane & 15, fq = lane >> 4;
    const int K = g.K, nt = K / BK;
    unsigned voffA[2], voffB[2];
#pragma unroll
    for (int i = 0; i < 2; ++i) { int R, C; stage_rc(tid * 16 + i * 8192, R, C); const int Rb = Epi::PERM ? ((R & ~31) + perm32(R & 31)) : R;
        voffA[i] = (unsigned)(R * K + C) * 2u; voffB[i] = (unsigned)(Rb * K + C) * 2u; }
    const size_t kstep = (size_t)(BK * 2);
    const size_t hstep = (size_t)HALF * K * 2;
    const size_t tstep = 2 * hstep;
    const unsigned ldsw = (unsigned)wid * 1024u;
    const int aoff = lds_byte(wr * 64 + fr, fq * 8), boff = lds_byte(wc * 32 + fr, fq * 8);
#define PG8_SA(b, h) (((b) * 2 + (h)) * HTB)
#define PG8_SB(b, h) ((4 + (b) * 2 + (h)) * HTB)
#define PG8_STAGE(bufoff, gbase, voff) do { _Pragma("unroll") for (int _i = 0; _i < 2; ++_i) \
        __builtin_amdgcn_global_load_lds((const unsigned*)((const char*)(gbase) + (voff)[_i]), (PG8_LAS unsigned*)(lds + (bufoff) + ldsw + _i * 8192), 16, 0, 0); } while (0)
#define PG8_LDA(dst, b, h) do { _Pragma("unroll") for (int m = 0; m < 4; ++m) _Pragma("unroll") for (int k = 0; k < 2; ++k) dst[m][k] = *(const PG8_LAS bf16x8*)(lds + PG8_SA(b, h) + aoff + m * 2048 + k * 1024); } while (0)
#define PG8_LDB(dst, b, h) do { _Pragma("unroll") for (int n = 0; n < 2; ++n) _Pragma("unroll") for (int k = 0; k < 2; ++k) dst[n][k] = *(const PG8_LAS bf16x8*)(lds + PG8_SB(b, h) + boff + n * 2048 + k * 1024); } while (0)
#define PG8_MMA(ai, bj, At, Bt) do { __builtin_amdgcn_s_setprio(1); _Pragma("unroll") for (int m = 0; m < 4; ++m) _Pragma("unroll") for (int n = 0; n < 2; ++n) _Pragma("unroll") for (int k = 0; k < 2; ++k) \
        acc[ai][bj][m][n] = __builtin_amdgcn_mfma_f32_16x16x32_bf16(Bt[n][k], At[m][k], acc[ai][bj][m][n], 0, 0, 0); __builtin_amdgcn_s_setprio(0); } while (0)
#define PG8_WAIT_V(n) asm volatile("s_waitcnt vmcnt(" #n ")" ::: "memory")
#define PG8_WAIT_L(n) asm volatile("s_waitcnt lgkmcnt(" #n ")" ::: "memory")
#define PG8_BAR __builtin_amdgcn_s_barrier()
#define PG8_SCHED __builtin_amdgcn_sched_barrier(0)
    Unit cur, nxt; int ui = 0;
    if (!S.next(0, cur)) return;
    f32x4 acc[2][2][4][2];
#pragma unroll
    for (int a = 0; a < 2; ++a)
#pragma unroll
        for (int b = 0; b < 2; ++b)
#pragma unroll
            for (int m = 0; m < 4; ++m)
#pragma unroll
                for (int n = 0; n < 2; ++n) acc[a][b][m][n] = (f32x4){0.f, 0.f, 0.f, 0.f};
    bf16x8 At[4][2], B0[2][2], B1[2][2];
    const char* cA = (const char*)g.A + (size_t)cur.pm * tstep; const char* cB = (const char*)g.Bt + (size_t)cur.pn * tstep;
    S.a_ready(cur);
    if constexpr (SP2) {
        PG8_STAGE(PG8_SB(0, 0), cB, voffB); PG8_STAGE(PG8_SB(0, 1), cB + hstep, voffB); PG8_STAGE(PG8_SA(0, 0), cA, voffA); PG8_STAGE(PG8_SA(0, 1), cA + hstep, voffA);
        if (wr == 1) PG8_BAR;
        PG8_WAIT_V(2); PG8_BAR;
        PG8_STAGE(PG8_SB(1, 0), cB + kstep, voffB); PG8_STAGE(PG8_SA(1, 0), cA + kstep, voffA); PG8_STAGE(PG8_SB(1, 1), cB + hstep + kstep, voffB);
        PG8_WAIT_V(6); PG8_BAR;
    } else {
        PG8_STAGE(PG8_SB(0, 0), cB, voffB); PG8_STAGE(PG8_SA(0, 0), cA, voffA); PG8_STAGE(PG8_SB(0, 1), cB + hstep, voffB); PG8_STAGE(PG8_SA(0, 1), cA + hstep, voffA);
        if (wr == 1) PG8_BAR;
        PG8_WAIT_V(4); PG8_BAR;
        PG8_STAGE(PG8_SB(1, 0), cB + kstep, voffB); PG8_STAGE(PG8_SA(1, 0), cA + kstep, voffA); PG8_STAGE(PG8_SB(1, 1), cB + hstep + kstep, voffB);
        PG8_WAIT_V(6); PG8_BAR;
    }
    for (;;) {
        const bool has_next = S.next(ui + 1, nxt);
        const char* nA = has_next ? (const char*)g.A + (size_t)nxt.pm * tstep : cA; const char* nB = has_next ? (const char*)g.Bt + (size_t)nxt.pn * tstep : cB;
        for (int t = 0; t < nt; t += 2) {
            const bool last = (t == nt - 2);
            const char* a1 = cA + (size_t)(t + 1) * kstep;
            const char* a2 = last ? nA : cA + (size_t)(t + 2) * kstep; const char* b2 = last ? nB : cB + (size_t)(t + 2) * kstep;
            const char* a3 = a2 + kstep; const char* b3 = b2 + kstep;
            if (last && has_next) S.a_ready(nxt);
            if constexpr (SP2) {
            PG8_LDB(B0, 0, 0); PG8_LDB(B1, 0, 1); PG8_SCHED; PG8_LDA(At, 0, 0); PG8_STAGE(PG8_SA(1, 1), a1 + hstep, voffA);
            PG8_WAIT_V(8); PG8_WAIT_L(0); PG8_BAR; PG8_MMA(0, 0, At, B0); PG8_MMA(0, 1, At, B1); PG8_BAR; PG8_SCHED;
            PG8_LDA(At, 0, 1); PG8_STAGE(PG8_SB(0, 0), b2, voffB); PG8_STAGE(PG8_SB(0, 1), b2 + hstep, voffB); PG8_STAGE(PG8_SA(0, 0), a2, voffA);
            PG8_WAIT_V(8); PG8_WAIT_L(0); PG8_BAR; PG8_MMA(1, 0, At, B0); PG8_MMA(1, 1, At, B1); PG8_BAR; PG8_SCHED;
            PG8_LDB(B0, 1, 0); PG8_LDB(B1, 1, 1); PG8_SCHED; PG8_LDA(At, 1, 0); PG8_STAGE(PG8_SA(0, 1), a2 + hstep, voffA);
            PG8_WAIT_V(8); PG8_WAIT_L(0); PG8_BAR; PG8_MMA(0, 0, At, B0); PG8_MMA(0, 1, At, B1); PG8_BAR; PG8_SCHED;
            PG8_LDA(At, 1, 1); PG8_STAGE(PG8_SB(1, 0), b3, voffB); PG8_STAGE(PG8_SB(1, 1), b3 + hstep, voffB); PG8_STAGE(PG8_SA(1, 0), a3, voffA);
            PG8_WAIT_V(8); PG8_WAIT_L(0); PG8_BAR; PG8_MMA(1, 0, At, B0); PG8_MMA(1, 1, At, B1); PG8_BAR; PG8_SCHED;
            } else {
            PG8_LDB(B0, 0, 0); PG8_SCHED; PG8_LDA(At, 0, 0); PG8_STAGE(PG8_SA(1, 1), a1 + hstep, voffA);
            PG8_WAIT_L(8); PG8_BAR; PG8_WAIT_L(0); PG8_MMA(0, 0, At, B0); PG8_BAR; PG8_SCHED;
            PG8_LDB(B1, 0, 1); PG8_STAGE(PG8_SB(0, 0), b2, voffB);
            PG8_BAR; PG8_WAIT_L(0); PG8_MMA(0, 1, At, B1); PG8_BAR;
            PG8_LDA(At, 0, 1); PG8_STAGE(PG8_SA(0, 0), a2, voffA);
            PG8_BAR; PG8_WAIT_L(0); PG8_MMA(1, 0, At, B0); PG8_BAR; PG8_SCHED;
            PG8_STAGE(PG8_SB(0, 1), b2 + hstep, voffB);
            PG8_WAIT_V(6); PG8_BAR; PG8_MMA(1, 1, At, B1); PG8_BAR;
            PG8_LDB(B0, 1, 0); PG8_SCHED; PG8_LDA(At, 1, 0); PG8_STAGE(PG8_SA(0, 1), a2 + hstep, voffA);
            PG8_WAIT_L(8); PG8_BAR; PG8_WAIT_L(0); PG8_MMA(0, 0, At, B0); PG8_BAR; PG8_SCHED;
            PG8_LDB(B1, 1, 1); PG8_STAGE(PG8_SB(1, 0), b3, voffB);
            PG8_BAR; PG8_WAIT_L(0); PG8_MMA(0, 1, At, B1); PG8_BAR;
            PG8_LDA(At, 1, 1); PG8_STAGE(PG8_SA(1, 0), a3, voffA);
            PG8_BAR; PG8_WAIT_L(0); PG8_MMA(1, 0, At, B0); PG8_BAR; PG8_SCHED;
            PG8_STAGE(PG8_SB(1, 1), b3 + hstep, voffB);
            PG8_WAIT_V(6); PG8_BAR; PG8_MMA(1, 1, At, B1); PG8_BAR;
            }
        }
        if constexpr (ALIGN_EPI) { if (wr == 0) PG8_BAR; }
        if constexpr (!Epi::AFTER_DRAIN) { E(acc, cur, wr, wc, fr, fq); S.done(cur); }
        if (!has_next) break;
#pragma unroll
        for (int a = 0; a < 2; ++a)
#pragma unroll
            for (int b = 0; b < 2; ++b)
#pragma unroll
                for (int m = 0; m < 4; ++m)
#pragma unroll
                    for (int n = 0; n < 2; ++n) acc[a][b][m][n] = (f32x4){0.f, 0.f, 0.f, 0.f};
        cur = nxt; cA = nA; cB = nB; ++ui;
        if constexpr (ALIGN_EPI) { if (wr == 1) PG8_BAR; }
    }
    PG8_WAIT_V(0);
    if constexpr (!ALIGN_EPI) { if (wr == 0) PG8_BAR; }
    PG8_BAR;
    if constexpr (Epi::AFTER_DRAIN) { E.fused(acc, cur, wr, wc, fr, fq, lds, wid, lane); S.done(cur); }
#undef PG8_SA
#undef PG8_SB
#undef PG8_STAGE
#undef PG8_LDA
#undef PG8_LDB
#undef PG8_MMA
#undef PG8_WAIT_V
#undef PG8_WAIT_L
#undef PG8_BAR
#undef PG8_SCHED
}
}
namespace pg8 {
__device__ __forceinline__ float silu_fast(float v) { return v * __builtin_amdgcn_rcpf(1.0f + __expf(-v)); }
struct EpiRes {
    static constexpr bool PERM = false, AFTER_DRAIN = false;
    const float* base; float* out; const float* gate_all;
    __device__ __forceinline__ void operator()(const f32x4 (&acc)[2][2][4][2], const Unit& u, int wr, int wc, int fr, int fq) const {
        const float* gate = gate_all + (u.pm >> 4) * 6144;
        const int col0 = u.pn * BM + wc * 32 + 4 * fq;
        f32x4 gv[2][2];
#pragma unroll
        for (int bj = 0; bj < 2; ++bj)
#pragma unroll
            for (int n = 0; n < 2; ++n) gv[bj][n] = *(const f32x4*)(gate + col0 + bj * HALF + n * 16);
#pragma unroll
        for (int ai = 0; ai < 2; ++ai)
#pragma unroll
            for (int m = 0; m < 4; ++m) { const size_t off = (size_t)(u.pm * BM + ai * HALF + wr * 64 + m * 16 + fr) * 1024 + col0;
#pragma unroll
                for (int bj = 0; bj < 2; ++bj)
#pragma unroll
                    for (int n = 0; n < 2; ++n) { const f32x4 bs = *(const f32x4*)(base + off + bj * HALF + n * 16); *(f32x4*)(out + off + bj * HALF + n * 16) = bs + gv[bj][n] * acc[ai][bj][m][n]; } }
    }
};
struct EpiSwiglu {
    static constexpr bool PERM = true, AFTER_DRAIN = false;
    bf16_t* O;
    __device__ __forceinline__ void operator()(const f32x4 (&acc)[2][2][4][2], const Unit& u, int wr, int wc, int fr, int fq) const {
        const int row0 = u.pm * BM + wr * 64 + fr, col0 = u.pn * HALF + wc * 32 + 8 * fq;
#pragma unroll
        for (int ai = 0; ai < 2; ++ai)
#pragma unroll
            for (int m = 0; m < 4; ++m) { bf16_t* rowp = O + (size_t)(row0 + ai * HALF + m * 16) * 2816 + col0;
                const f32x4 g0 = acc[ai][0][m][0], g1 = acc[ai][0][m][1], u0 = acc[ai][1][m][0], u1 = acc[ai][1][m][1];
                u32x4 w; w.x = cvt_pk_bf16(silu_fast(g0[0]) * u0[0], silu_fast(g0[1]) * u0[1]); w.y = cvt_pk_bf16(silu_fast(g0[2]) * u0[2], silu_fast(g0[3]) * u0[3]);
                w.z = cvt_pk_bf16(silu_fast(g1[0]) * u1[0], silu_fast(g1[1]) * u1[1]); w.w = cvt_pk_bf16(silu_fast(g1[2]) * u1[2], silu_fast(g1[3]) * u1[3]);
                *(u32x4*)rowp = w; }
    }
};
struct EpiWin {
    static constexpr bool PERM = true, AFTER_DRAIN = false;
    bf16_t *QR, *KR, *VR, *GR;
    __device__ __forceinline__ void operator()(const f32x4 (&acc)[2][2][4][2], const Unit& u, int wr, int wc, int fr, int fq) const {
        const int pn = u.pn; bf16_t* base; int pitch, colt; bool act = false;
        if (pn < 4) { base = QR; pitch = 1024; colt = pn * BM; } else if (pn < 8) { base = KR; pitch = 1024; colt = (pn - 4) * BM; }
        else if (pn < 16) { base = VR; pitch = 2048; colt = (pn - 8) * BM; } else { base = GR; pitch = 2048; colt = (pn - 16) * BM; act = true; }
        const int row0 = u.pm * BM + wr * 64 + fr, col0 = colt + wc * 32 + 8 * fq;
#pragma unroll
        for (int ai = 0; ai < 2; ++ai)
#pragma unroll
            for (int m = 0; m < 4; ++m) { bf16_t* rowp = base + (size_t)(row0 + ai * HALF + m * 16) * pitch + col0;
#pragma unroll
                for (int bj = 0; bj < 2; ++bj) { f32x4 v0 = acc[ai][bj][m][0], v1 = acc[ai][bj][m][1];
                    if (act) { v0 = (f32x4){silu_fast(v0[0]), silu_fast(v0[1]), silu_fast(v0[2]), silu_fast(v0[3])}; v1 = (f32x4){silu_fast(v1[0]), silu_fast(v1[1]), silu_fast(v1[2]), silu_fast(v1[3])}; }
                    u32x4 w; w.x = cvt_pk_bf16(v0[0], v0[1]); w.y = cvt_pk_bf16(v0[2], v0[3]); w.z = cvt_pk_bf16(v1[0], v1[1]); w.w = cvt_pk_bf16(v1[2], v1[3]);
                    *(u32x4*)(rowp + bj * HALF) = w; } }
    }
};
}
#define GAS __attribute__((address_space(1)))
#define LAS __attribute__((address_space(3)))
typedef unsigned short bf16;
typedef unsigned v4u __attribute__((ext_vector_type(4)));
typedef float f32x4 __attribute__((ext_vector_type(4)));
typedef short bf16x8 __attribute__((ext_vector_type(8)));
typedef GAS unsigned gu32;
typedef GAS unsigned long long gu64;
#define RLX_AGENT __ATOMIC_RELAXED, __HIP_MEMORY_SCOPE_AGENT
#define LDS_WAIT() asm volatile("s_waitcnt lgkmcnt(0)" ::: "memory")
#define VM_WAIT() asm volatile("s_waitcnt vmcnt(0)" ::: "memory")
__device__ __forceinline__ unsigned long long rt() { return __builtin_amdgcn_s_memrealtime(); }
__device__ __forceinline__ unsigned f2bf(float f) { unsigned u = __builtin_bit_cast(unsigned, f); return (u + 0x7fffu + ((u >> 16) & 1u)) >> 16; }
__device__ __forceinline__ unsigned pk2(float lo, float hi) { return f2bf(lo) | (f2bf(hi) << 16); }

#define XB_TMO      128
#define XB_XCNT(j)  (256  + 64 * (j))
#define XB_XSUB(j)  (1280 + 64 * (j))
#define XB_XGEN(j)  (2304 + 64 * (j))
#define XB_TOP      3328
#define XB_TOPGEN   3392
#define XCD_BAR_WORDS 3456
#define XB_SPIN_CAP (1u << 18)

__device__ __forceinline__ unsigned xb_ld(unsigned* p)              { return __hip_atomic_load(p, __ATOMIC_RELAXED, __HIP_MEMORY_SCOPE_AGENT); }
__device__ __forceinline__ unsigned xb_add(unsigned* p, unsigned v) { return __hip_atomic_fetch_add(p, v, __ATOMIC_RELAXED, __HIP_MEMORY_SCOPE_AGENT); }
__device__ __forceinline__ unsigned xb_xcc_id() { return (unsigned)__builtin_amdgcn_s_getreg((3 << 11) | 20) & 0xFu; }
#define XB_SPIN(cond, bar) do { unsigned _sp = 0; while (cond) { __builtin_amdgcn_s_sleep(1); \
    if ((++_sp & 255u) == 0u) { if (xb_ld(&(bar)[XB_TMO])) break; if (_sp > XB_SPIN_CAP) { atomicAdd(&(bar)[XB_TMO], 1u); break; } } } } while (0)

struct XcdBarrier {
    unsigned* bar; unsigned x;
    volatile LAS unsigned* st;
};

__device__ __forceinline__ XcdBarrier xcd_barrier_post(unsigned* bar, volatile LAS unsigned* st) {
    XcdBarrier b; b.bar = bar; b.x = xb_xcc_id(); b.st = st;
    if (threadIdx.x == 0) (void)xb_add(&bar[XB_XCNT(b.x)], 1u);
    return b;
}
__device__ __forceinline__ void xcd_barrier_complete(unsigned* bar, unsigned x, unsigned& nloc, unsigned& nx) {
    const unsigned G = gridDim.x * gridDim.y * gridDim.z;
    unsigned sum, cnt, mine, sp = 0u;
    for (;;) {
        sum = 0u; cnt = 0u; mine = 0u;
#pragma unroll
        for (unsigned j = 0; j < 16; ++j) { const unsigned c = xb_ld(&bar[XB_XCNT(j)]); sum += c; cnt += (c > 0u) ? 1u : 0u; mine = (j == x) ? c : mine; }
        if (sum == G) break;
        __builtin_amdgcn_s_sleep(1);
        if ((++sp & 255u) == 0u) { if (xb_ld(&bar[XB_TMO])) break; if (sp > XB_SPIN_CAP) { atomicAdd(&bar[XB_TMO], 1u); break; } }
    }
    nloc = mine > 0u ? mine : 1u; nx = cnt > 0u ? cnt : 1u;
}

__device__ __forceinline__ void xcd_barrier(const XcdBarrier& b) {
    asm volatile("s_waitcnt vmcnt(0)" ::: "memory");
    __syncthreads();
    if (threadIdx.x == 0) {
        unsigned* bar = b.bar;
        __builtin_amdgcn_s_waitcnt(0);
        unsigned nloc = b.st[0], nx = b.st[1];
        if (nloc == 0u) { xcd_barrier_complete(bar, b.x, nloc, nx); b.st[0] = nloc; b.st[1] = nx; }
        const unsigned old = xb_add(&bar[XB_XSUB(b.x)], 1u);
        const unsigned gen = old / nloc;
        if (old + 1u == (gen + 1u) * nloc) {
            __builtin_amdgcn_fence(__ATOMIC_RELEASE, "agent");
            asm volatile("s_waitcnt vmcnt(0)" ::: "memory");
            const unsigned og = xb_add(&bar[XB_TOP], 1u);
            const unsigned tg = og / nx;
            if (og + 1u == (tg + 1u) * nx) xb_add(&bar[XB_TOPGEN], 1u);
            else XB_SPIN(xb_ld(&bar[XB_TOPGEN]) == tg, bar);
            __builtin_amdgcn_fence(__ATOMIC_ACQUIRE, "agent");
            xb_add(&bar[XB_XGEN(b.x)], 1u);
            asm volatile("s_waitcnt vmcnt(0)" ::: "memory");
        } else {
            XB_SPIN(xb_ld(&bar[XB_XGEN(b.x)]) == gen, bar);
            __builtin_amdgcn_fence(__ATOMIC_ACQUIRE, "agent");
            asm volatile("s_waitcnt vmcnt(0)" ::: "memory");
        }
    }
    __syncthreads();
}
constexpr int NWAVES = 8;
constexpr int NB = 4, SEQ = 4096, DM = 1024, MT = NB * SEQ;
constexpr int NQKV = 3072, DFF = 2816, NGU = 5632, NRIN = 6144, RV = 2048;
constexpr size_t MiB = 1u << 20;
constexpr size_t WS_CTL = 0, CTL_ZERO_BYTES = 1 * MiB;
constexpr size_t WS_ADA = 1 * MiB;
constexpr size_t WS_KMEAN = 1 * MiB + 256 * 1024;
constexpr size_t WS_CSA = 2 * MiB;
constexpr size_t WS_CSR = 3 * MiB;
constexpr size_t WS_H = 9 * MiB;
constexpr size_t WS_WIN = 41 * MiB;
constexpr size_t WS_WQKV = 53 * MiB, WS_WO = 59 * MiB, WS_GU0 = 61 * MiB, WS_D0 = 72 * MiB;
constexpr size_t WS_Q = 78 * MiB, WS_K = 110 * MiB, WS_V = 142 * MiB;
constexpr size_t WS_HMID0 = 78 * MiB;
constexpr size_t WS_QR = 53 * MiB, WS_KR = 85 * MiB, WS_VR = 117 * MiB, WS_GR = 181 * MiB;
constexpr size_t WS_GU1 = 245 * MiB;
constexpr size_t WS_WRO = 41 * MiB, WS_D1 = 45 * MiB;
constexpr size_t WS_HMID1 = 53 * MiB;
constexpr size_t WS_END = 256 * MiB;
constexpr int CW_TMO = 0, CW_CODE = 1, CW_BAR = 4096;
constexpr int RING_OFF = 0, RING_BYTES = 131072, LDSCTL_OFF = RING_BYTES, MISC_OFF = LDSCTL_OFF + 320, LDS_BYTES = 147456;

typedef unsigned v2u __attribute__((ext_vector_type(2)));
typedef float f32x2 __attribute__((ext_vector_type(2)));
__device__ __forceinline__ float bflo(unsigned w) { return __builtin_bit_cast(float, w << 16); }
__device__ __forceinline__ float bfhi(unsigned w) { return __builtin_bit_cast(float, w & 0xffff0000u); }
__device__ __forceinline__ float bf1(bf16 h) { return __builtin_bit_cast(float, (unsigned)h << 16); }
__device__ __forceinline__ void unpack8(v4u w, float (&f)[8]) { f[0] = bflo(w.x); f[1] = bfhi(w.x); f[2] = bflo(w.y); f[3] = bfhi(w.y); f[4] = bflo(w.z); f[5] = bfhi(w.z); f[6] = bflo(w.w); f[7] = bfhi(w.w); }
struct Frame {
    LAS unsigned char* lds; volatile LAS unsigned* MISC; gu32* ctl;
    int tid, lane, wave, vcu, G;
    const float *x, *c, *ada_w, *ada_b, *ng, *wqkv, *wo, *win, *gn, *rwo, *wgu, *wdn, *fng;
    float* out; unsigned char* ws;
};
__device__ __forceinline__ float wave_sum(float v) {
#pragma unroll
    for (int o = 1; o < 64; o <<= 1) v += __shfl_xor(v, o);
    return v;
}
__device__ __forceinline__ float silu_f(float v) { return v / (1.f + __expf(-v)); }

__device__ __forceinline__ void transpose_item(const float* W, int K, int N, bf16* WT, int k0, int n0, int drow0, LAS float* scr, int lane) {
#pragma unroll 8
    for (int i = 0; i < 32; ++i) { const int kk = 2 * i + (lane >> 5); scr[kk * 33 + (lane & 31)] = W[(size_t)(k0 + kk) * N + n0 + (lane & 31)]; }
    LDS_WAIT(); asm volatile("" ::: "memory");
    const int c = lane & 7;
#pragma unroll
    for (int j = 0; j < 4; ++j) { const int n = (lane >> 3) + 8 * j; const LAS float* s = scr + (8 * c) * 33 + n;
        v4u o; o.x = pk2(s[0 * 33], s[1 * 33]); o.y = pk2(s[2 * 33], s[3 * 33]); o.z = pk2(s[4 * 33], s[5 * 33]); o.w = pk2(s[6 * 33], s[7 * 33]);
        *(GAS v4u*)(WT + (size_t)(drow0 + n) * K + k0 + 8 * c) = o; }
    LDS_WAIT(); asm volatile("" ::: "memory");
}
__device__ __forceinline__ void convert_matrix(Frame& F, const float* W, int K, int N, bf16* WT, bool GU, int& itbase) {
    LAS float* scr = (LAS float*)(F.lds + RING_OFF + F.wave * 16384);
    const int gw = F.vcu * NWAVES + F.wave, NGW = F.G * NWAVES;
    const int nblk = N / 32, nitems = (K / 64) * nblk;
    int first = (gw - itbase % NGW + NGW) % NGW;
    for (int it = first; it < nitems; it += NGW) {
        const int kb = it / nblk, nb = it % nblk, n0 = 32 * nb;
        int drow0 = n0;
        if (GU) drow0 = (n0 < DFF) ? (n0 / 128) * 256 + (n0 % 128) : ((n0 - DFF) / 128) * 256 + 128 + ((n0 - DFF) % 128);
        transpose_item(W, K, N, WT, 64 * kb, n0, drow0, scr, F.lane);
    }
    itbase += nitems;
}

__device__ __forceinline__ void p0_prologue(Frame& F) {
    {
        LAS float* sc = (LAS float*)(F.lds + RING_OFF);
        LAS float* red = (LAS float*)(F.lds + RING_OFF + 16384);
        for (int u = blockIdx.x; u < 192; u += F.G) {
            for (int i = F.tid; i < 4096; i += 512) sc[i] = silu_f(F.c[i]);
            __syncthreads();
            const int l = u / 96, n = (u % 96) * 64 + F.lane;
            const float* wp = F.ada_w + (size_t)l * 1024 * 6144 + n;
            float a0 = 0.f, a1 = 0.f, a2 = 0.f, a3 = 0.f;
            const int kb = F.wave * 128;
#pragma unroll 8
            for (int k = kb; k < kb + 128; ++k) { const float wv = wp[(size_t)k * 6144]; a0 += sc[k] * wv; a1 += sc[1024 + k] * wv; a2 += sc[2048 + k] * wv; a3 += sc[3072 + k] * wv; }
            red[(F.wave * 4 + 0) * 64 + F.lane] = a0; red[(F.wave * 4 + 1) * 64 + F.lane] = a1; red[(F.wave * 4 + 2) * 64 + F.lane] = a2; red[(F.wave * 4 + 3) * 64 + F.lane] = a3;
            __syncthreads();
            if (F.wave < 4) { float s = 0.f;
#pragma unroll
                for (int w = 0; w < 8; ++w) s += red[(w * 4 + F.wave) * 64 + F.lane];
                float* m = (float*)(F.ws + WS_ADA);
                m[(size_t)(l * 4 + F.wave) * 6144 + n] = s + F.ada_b[l * 6144 + n]; }
            __syncthreads();
        }
    }
    {
        f32x2* csa = (f32x2*)(F.ws + WS_CSA); f32x2* csr = (f32x2*)(F.ws + WS_CSR);
        const int gt = F.vcu * 512 + F.tid, NT = F.G * 512;
        for (int i = gt; i < SEQ * 32; i += NT) { const int pos = i >> 5, j = i & 31; const double rev = (double)pos * INV64[j] * 0.15915494309189535; const float a = (float)((rev - rint(rev)) * 6.283185307179586); csa[i] = (f32x2){__cosf(a), __sinf(a)}; }
        for (int i = gt; i < SEQ * 128; i += NT) { const int pos = i >> 7, j = i & 127; const double rev = (double)pos * INV256[j] * 0.15915494309189535; const float a = (float)((rev - rint(rev)) * 6.283185307179586); csr[i] = (f32x2){__cosf(a), __sinf(a)}; }
    }
    __syncthreads();
    int itbase = 0;
    convert_matrix(F, F.wqkv, DM, NQKV, (bf16*)(F.ws + WS_WQKV), false, itbase);
    convert_matrix(F, F.wo, DM, DM, (bf16*)(F.ws + WS_WO), false, itbase);
    convert_matrix(F, F.wgu, DM, NGU, (bf16*)(F.ws + WS_GU0), true, itbase);
    convert_matrix(F, F.wdn, DFF, DM, (bf16*)(F.ws + WS_D0), false, itbase);
    convert_matrix(F, F.win, DM, NRIN, (bf16*)(F.ws + WS_WIN), false, itbase);
}
__device__ __forceinline__ void convert_set_b(Frame& F) {
    int itbase = 0;
    convert_matrix(F, F.rwo, RV, DM, (bf16*)(F.ws + WS_WRO), false, itbase);
    convert_matrix(F, F.wgu + (size_t)DM * NGU, DM, NGU, (bf16*)(F.ws + WS_GU1), true, itbase);
    convert_matrix(F, F.wdn + (size_t)DFF * DM, DFF, DM, (bf16*)(F.ws + WS_D1), false, itbase);
}

__device__ __forceinline__ void norm_mod_phase(Frame& F, const float* xsrc, const float* gain, int layer, int shift_chunk) {
    const int gw = F.vcu * NWAVES + F.wave, NGW = F.G * NWAVES;
    bf16* H = (bf16*)(F.ws + WS_H);
    const float* ada = (const float*)(F.ws + WS_ADA);
    for (int m = gw; m < MT; m += NGW) {
        const int b = m >> 12;
        const float* am = ada + (size_t)(layer * 4 + b) * 6144 + shift_chunk * 1024;
        const GAS f32x4* xr = (const GAS f32x4*)(xsrc + (size_t)m * DM) + F.lane;
        f32x4 v[4]; float s = 0.f;
#pragma unroll
        for (int j = 0; j < 4; ++j) { v[j] = xr[64 * j]; s += (v[j].x * v[j].x + v[j].y * v[j].y) + (v[j].z * v[j].z + v[j].w * v[j].w); }
        const float rstd = 1.0f / sqrtf(wave_sum(s) * (1.f / DM) + 1e-6f);
        GAS v2u* o8 = (GAS v2u*)(H + (size_t)m * DM) + F.lane;
#pragma unroll
        for (int j = 0; j < 4; ++j) {
            const f32x4 g = *((const f32x4*)gain + F.lane + 64 * j), sh = *((const f32x4*)am + F.lane + 64 * j), sc = *((const f32x4*)(am + 1024) + F.lane + 64 * j);
            const f32x4 r = v[j] * rstd * g * (sc + 1.0f) + sh;
            o8[64 * j] = (v2u){pk2(r.x, r.y), pk2(r.z, r.w)};
        }
    }
}
__device__ __forceinline__ void final_norm_phase(Frame& F) {
    const int gw = F.vcu * NWAVES + F.wave, NGW = F.G * NWAVES;
    for (int m = gw; m < MT; m += NGW) {
        GAS f32x4* xr = (GAS f32x4*)(F.out + (size_t)m * DM) + F.lane;
        f32x4 v[4]; float s = 0.f;
#pragma unroll
        for (int j = 0; j < 4; ++j) { v[j] = xr[64 * j]; s += (v[j].x * v[j].x + v[j].y * v[j].y) + (v[j].z * v[j].z + v[j].w * v[j].w); }
        const float rstd = 1.0f / sqrtf(wave_sum(s) * (1.f / DM) + 1e-6f);
#pragma unroll
        for (int j = 0; j < 4; ++j) { const f32x4 g = *((const f32x4*)F.fng + F.lane + 64 * j); xr[64 * j] = v[j] * rstd * g; }
    }
}
__device__ __forceinline__ void rope_att_phase(Frame& F) {
    const int gt = F.vcu * 512 + F.tid, NT = F.G * 512;
    const f32x2* csa = (const f32x2*)(F.ws + WS_CSA);
    for (int i = gt; i < MT * 2 * 8 * 4; i += NT) {
        const int i8 = i & 3, hd = (i >> 2) & 7, which = (i >> 5) & 1, row = i >> 6, pos = row & (SEQ - 1);
        bf16* p = (bf16*)(F.ws + (which ? WS_K : WS_Q)) + (size_t)row * DM + (8 + hd) * 64 + i8 * 8;
        const v4u a = *(const v4u*)p, b = *(const v4u*)(p + 32);
        float x1[8], x2[8], o1[8], o2[8]; unpack8(a, x1); unpack8(b, x2);
#pragma unroll
        for (int j = 0; j < 8; ++j) { const f32x2 cs = csa[pos * 32 + i8 * 8 + j]; o1[j] = x1[j] * cs.x - x2[j] * cs.y; o2[j] = x2[j] * cs.x + x1[j] * cs.y; }
        *(v4u*)p = (v4u){pk2(o1[0], o1[1]), pk2(o1[2], o1[3]), pk2(o1[4], o1[5]), pk2(o1[6], o1[7])};
        *(v4u*)(p + 32) = (v4u){pk2(o2[0], o2[1]), pk2(o2[2], o2[3]), pk2(o2[4], o2[5]), pk2(o2[6], o2[7])};
    }
}
__device__ __forceinline__ void rope_ret_phase(Frame& F) {
    const int gt = F.vcu * 512 + F.tid, NT = F.G * 512;
    const f32x2* csr = (const f32x2*)(F.ws + WS_CSR);
    for (int i = gt; i < MT * 2 * 4 * 16; i += NT) {
        const int i8 = i & 15, hd = (i >> 4) & 3, which = (i >> 6) & 1, row = i >> 7, pos = row & (SEQ - 1);
        bf16* p = (bf16*)(F.ws + (which ? WS_KR : WS_QR)) + (size_t)row * DM + hd * 256 + i8 * 8;
        const v4u a = *(const v4u*)p, b = *(const v4u*)(p + 128);
        const float scl = which ? 0.0625f : 1.0f;
        float x1[8], x2[8], o1[8], o2[8]; unpack8(a, x1); unpack8(b, x2);
#pragma unroll
        for (int j = 0; j < 8; ++j) { const f32x2 cs = csr[pos * 128 + i8 * 8 + j]; o1[j] = (x1[j] * cs.x - x2[j] * cs.y) * scl; o2[j] = (x2[j] * cs.x + x1[j] * cs.y) * scl; }
        *(v4u*)p = (v4u){pk2(o1[0], o1[1]), pk2(o1[2], o1[3]), pk2(o1[4], o1[5]), pk2(o1[6], o1[7])};
        *(v4u*)(p + 128) = (v4u){pk2(o2[0], o2[1]), pk2(o2[2], o2[3]), pk2(o2[4], o2[5]), pk2(o2[6], o2[7])};
    }
}
__device__ __forceinline__ void kmean_phase(Frame& F) {
    const int gw = F.vcu * NWAVES + F.wave, NGW = F.G * NWAVES;
    const bf16* K = (const bf16*)(F.ws + WS_K); float* km = (float*)(F.ws + WS_KMEAN);
    for (int u = gw; u < NB * 8 * 16; u += NGW) {
        const int n = u & 15, hd = (u >> 4) & 7, b = u >> 7;
        const bf16* kp = K + (size_t)(b * SEQ + n * 256) * DM + (8 + hd) * 64 + F.lane;
        float s = 0.f;
#pragma unroll 8
        for (int j = 0; j < 256; ++j) s += bf1(kp[(size_t)j * DM]);
        km[u * 64 + F.lane] = s * (1.0f / 256.0f);
    }
}
__device__ __forceinline__ void sb_unit(Frame& F, int b, int h, int blk) {
    const bf16* Q = (const bf16*)(F.ws + WS_Q); const bf16* K = (const bf16*)(F.ws + WS_K); const bf16* V = (const bf16*)(F.ws + WS_V);
    const int t = blk * 64 + F.lane, tmax = blk * 64 + 63;
    const size_t rb = (size_t)b * SEQ;
    v4u qv[8]; float o[64];
    { const v4u* qp = (const v4u*)(Q + (rb + t) * DM + h * 64);
#pragma unroll
      for (int c = 0; c < 8; ++c) { qv[c] = qp[c];
#pragma unroll
          for (int j = 0; j < 8; ++j) o[c * 8 + j] = 0.f; } }
    float R = 0.f; bool done = false;
#pragma unroll 1
    for (int s = tmax - 1; s >= 0; --s) {
        const v4u* kp = (const v4u*)(K + (rb + s) * DM + h * 64);
        float z = 0.f;
#pragma unroll
        for (int c = 0; c < 8; ++c) { float f[8], qf[8]; unpack8(kp[c], f); unpack8(qv[c], qf);
#pragma unroll
            for (int j = 0; j < 8; ++j) z += qf[j] * f[j]; }
        z *= 0.125f;
        if (s < t && !done) {
            const float L = -(fmaxf(z, 0.f) + log1pf(__expf(-fabsf(z))));
            const float a = __expf(z + L + R);
            const v4u* vp = (const v4u*)(V + (rb + s) * DM + h * 64);
#pragma unroll
            for (int c = 0; c < 8; ++c) { float f[8]; unpack8(vp[c], f);
#pragma unroll
                for (int j = 0; j < 8; ++j) o[c * 8 + j] += a * f[j]; }
            R += L;
            if (R < -100.f) done = true;
        }
        if (__all(done || t == 0)) break;
    }
    v4u* op = (v4u*)((bf16*)(F.ws + WS_Q) + (rb + t) * DM + h * 64);
#pragma unroll
    for (int c = 0; c < 8; ++c) op[c] = (v4u){pk2(o[c * 8], o[c * 8 + 1]), pk2(o[c * 8 + 2], o[c * 8 + 3]), pk2(o[c * 8 + 4], o[c * 8 + 5]), pk2(o[c * 8 + 6], o[c * 8 + 7])};
}
__device__ __forceinline__ void moba_unit(Frame& F, int b, int hd, int blk) {
    const int head = 8 + hd;
    const bf16* Q = (const bf16*)(F.ws + WS_Q); const bf16* K = (const bf16*)(F.ws + WS_K); const bf16* V = (const bf16*)(F.ws + WS_V);
    const float* kmean = (const float*)(F.ws + WS_KMEAN) + (size_t)(b * 8 + hd) * 16 * 64;
    const int t = blk * 64 + F.lane, tmax = blk * 64 + 63, own = blk >> 2;
    const size_t rb = (size_t)b * SEQ;
    v4u qv[8]; float o[64];
    { const v4u* qp = (const v4u*)(Q + (rb + t) * DM + head * 64);
#pragma unroll
      for (int c = 0; c < 8; ++c) { qv[c] = qp[c];
#pragma unroll
          for (int j = 0; j < 8; ++j) o[c * 8 + j] = 0.f; } }
    unsigned sel = 0u;
    if (own <= 3) sel = (1u << own) - 1u;
    else {
        float b1 = -3e38f, b2 = -3e38f, b3 = -3e38f; int i1 = 0, i2 = 0, i3 = 0;
#pragma unroll 1
        for (int n = 0; n < own; ++n) {
            const float* km = kmean + n * 64; float a = 0.f;
#pragma unroll
            for (int c = 0; c < 8; ++c) { float qf[8]; unpack8(qv[c], qf);
#pragma unroll
                for (int j = 0; j < 8; ++j) a += qf[j] * km[c * 8 + j]; }
            if (a > b1) { b3 = b2; i3 = i2; b2 = b1; i2 = i1; b1 = a; i1 = n; }
            else if (a > b2) { b3 = b2; i3 = i2; b2 = a; i2 = n; }
            else if (a > b3) { b3 = a; i3 = n; }
        }
        sel = (1u << i1) | (1u << i2) | (1u << i3);
    }
    float m = -1e30f, l = 0.f;
    for (int n = 0; n <= own; ++n) {
        const bool mine = (n == own) || ((sel >> n) & 1u);
        if (!__any(mine)) continue;
        const int s1 = (n == own) ? tmax : n * 256 + 255;
#pragma unroll 1
        for (int s = n * 256; s <= s1; ++s) {
            const v4u* kp = (const v4u*)(K + (rb + s) * DM + head * 64);
            float sc = 0.f;
#pragma unroll
            for (int c = 0; c < 8; ++c) { float f[8], qf[8]; unpack8(kp[c], f); unpack8(qv[c], qf);
#pragma unroll
                for (int j = 0; j < 8; ++j) sc += qf[j] * f[j]; }
            sc *= 0.125f;
            if (mine && s <= t) {
                if (sc > m) { const float f = __expf(m - sc); l *= f;
#pragma unroll
                    for (int d = 0; d < 64; ++d) o[d] *= f;
                    m = sc; }
                const float p = __expf(sc - m); l += p;
                const v4u* vp = (const v4u*)(V + (rb + s) * DM + head * 64);
#pragma unroll
                for (int c = 0; c < 8; ++c) { float f[8]; unpack8(vp[c], f);
#pragma unroll
                    for (int j = 0; j < 8; ++j) o[c * 8 + j] += p * f[j]; }
            }
        }
    }
    const float il = 1.0f / l;
    v4u* op = (v4u*)((bf16*)(F.ws + WS_Q) + (rb + t) * DM + head * 64);
#pragma unroll
    for (int c = 0; c < 8; ++c) op[c] = (v4u){pk2(o[c * 8] * il, o[c * 8 + 1] * il), pk2(o[c * 8 + 2] * il, o[c * 8 + 3] * il), pk2(o[c * 8 + 4] * il, o[c * 8 + 5] * il), pk2(o[c * 8 + 6] * il, o[c * 8 + 7] * il)};
}
__device__ __forceinline__ void attn_naive_phase(Frame& F) {
    const int gw = F.vcu * NWAVES + F.wave, NGW = F.G * NWAVES;
    for (int u = gw; u < NB * 64 * 16; u += NGW) {
        const int head = u & 15, blk = (u >> 4) & 63, b = u >> 10;

#ifndef NOSB
        if (head < 8) sb_unit(F, b, head, blk);
#endif
#ifndef NOMOBA
        if (head >= 8) moba_unit(F, b, head - 8, blk);
#endif

    }
}
__device__ __forceinline__ void ret_naive_phase(Frame& F) {
    LAS float* red = (LAS float*)(F.lds + RING_OFF);
    const bf16* QR = (const bf16*)(F.ws + WS_QR); const bf16* KR = (const bf16*)(F.ws + WS_KR); bf16* VR = (bf16*)(F.ws + WS_VR);
    const int tid = F.tid, dvi = tid & 31, dkg = tid >> 5;
    for (int u = blockIdx.x; u < NB * 4 * 16; u += F.G) {
        const int sl = u & 15, h = (u >> 4) & 3, b = u >> 6;
        const float gamma = 1.0f - 1.0f / (float)(32 << h);
        float S[16];
#pragma unroll
        for (int i = 0; i < 16; ++i) S[i] = 0.f;
        const size_t rb = (size_t)b * SEQ;
        const bf16* qb = QR + rb * DM + h * 256 + dkg * 16; const bf16* kb = KR + rb * DM + h * 256 + dkg * 16;
        bf16* vb = VR + rb * RV + h * 512 + sl * 32 + dvi;
        v4u qn0 = *(const v4u*)qb, qn1 = *(const v4u*)(qb + 8), kn0 = *(const v4u*)kb, kn1 = *(const v4u*)(kb + 8); bf16 vn = vb[0];
        for (int t = 0; t < SEQ; ++t) {
            float qc[16], kc[16]; { float f[8]; unpack8(qn0, f);
#pragma unroll
                for (int j = 0; j < 8; ++j) qc[j] = f[j];
                unpack8(qn1, f);
#pragma unroll
                for (int j = 0; j < 8; ++j) qc[8 + j] = f[j];
                unpack8(kn0, f);
#pragma unroll
                for (int j = 0; j < 8; ++j) kc[j] = f[j];
                unpack8(kn1, f);
#pragma unroll
                for (int j = 0; j < 8; ++j) kc[8 + j] = f[j]; }
            const float v = bf1(vn);
            if (t + 1 < SEQ) { const size_t o1 = (size_t)(t + 1) * DM; qn0 = *(const v4u*)(qb + o1); qn1 = *(const v4u*)(qb + o1 + 8); kn0 = *(const v4u*)(kb + o1); kn1 = *(const v4u*)(kb + o1 + 8); vn = vb[(size_t)(t + 1) * RV]; }
            float po = 0.f;
#pragma unroll
            for (int i = 0; i < 16; ++i) { S[i] = gamma * S[i] + kc[i] * v; po += qc[i] * S[i]; }
            red[((t & 1) * 16 + dkg) * 32 + dvi] = po;
            __syncthreads();
            if (tid < 32) { float s = 0.f;
#pragma unroll
                for (int j = 0; j < 16; ++j) s += red[((t & 1) * 16 + j) * 32 + tid];
                vb[(size_t)t * RV] = (bf16)f2bf(s); }
        }
        __syncthreads();
    }
}
__device__ __forceinline__ void gn_gate_phase(Frame& F) {
    const int gw = F.vcu * NWAVES + F.wave, NGW = F.G * NWAVES;
    bf16* VR = (bf16*)(F.ws + WS_VR); const bf16* GR = (const bf16*)(F.ws + WS_GR);
    for (int u = gw; u < MT * 4; u += NGW) {
        const int h = u & 3, row = u >> 2;
        bf16* op = VR + (size_t)row * RV + h * 512 + F.lane * 8;
        float v[8], g[8]; unpack8(*(const v4u*)op, v); unpack8(*(const v4u*)(GR + (size_t)row * RV + h * 512 + F.lane * 8), g);
        float s = 0.f;
#pragma unroll
        for (int i = 0; i < 8; ++i) s += v[i];
        const float mu = wave_sum(s) * (1.0f / 512.0f); float q = 0.f;
#pragma unroll
        for (int i = 0; i < 8; ++i) { v[i] -= mu; q += v[i] * v[i]; }
        const float rs = 1.0f / sqrtf(wave_sum(q) * (1.0f / 512.0f) + 1e-5f);
        const float* gg = F.gn + h * 512 + F.lane * 8;
        float r[8];
#pragma unroll
        for (int i = 0; i < 8; ++i) r[i] = g[i] * (v[i] * rs * gg[i]);
        *(v4u*)op = (v4u){pk2(r[0], r[1]), pk2(r[2], r[3]), pk2(r[4], r[5]), pk2(r[6], r[7])};
    }
}
#ifndef MK_N_LAUNCHES
#define MK_N_LAUNCHES 1
#endif
constexpr int NPH = 20;
struct Args { const float* in[13]; float* out; unsigned char* ws; int ph_lo, ph_hi, li, pad; };
__global__ void __launch_bounds__(NWAVES * 64, 2) mk_fwd(Args args) {
    extern __shared__ __attribute__((aligned(16))) unsigned char lds[];
    Frame F;
    F.lds = (LAS unsigned char*)lds; F.MISC = (volatile LAS unsigned*)(F.lds + MISC_OFF);
    F.tid = threadIdx.x; F.lane = F.tid & 63; F.wave = __builtin_amdgcn_readfirstlane(F.tid >> 6);
    F.G = gridDim.x; { const int bx = blockIdx.x; F.vcu = (F.G % 8 == 0) ? (bx % 8) * (F.G / 8) + bx / 8 : bx; }
    F.ws = args.ws; F.ctl = (gu32*)(args.ws + WS_CTL); F.out = args.out;
    F.x = args.in[0]; F.c = args.in[1]; F.ada_w = args.in[2]; F.ada_b = args.in[3]; F.ng = args.in[4]; F.wqkv = args.in[5]; F.wo = args.in[6];
    F.win = args.in[7]; F.gn = args.in[8]; F.rwo = args.in[9]; F.wgu = args.in[10]; F.wdn = args.in[11]; F.fng = args.in[12];
    for (int u = F.tid; u < (LDS_BYTES - LDSCTL_OFF) / 4; u += NWAVES * 64) ((LAS unsigned*)(F.lds + LDSCTL_OFF))[u] = 0u;
    __syncthreads();
    const int lo = args.ph_lo, hi = args.ph_hi;
    XcdBarrier bar; bar.bar = (unsigned*)(F.ctl + CW_BAR); bar.x = 0; bar.st = nullptr;
    if (hi - lo > 1) bar = xcd_barrier_post((unsigned*)(F.ctl + CW_BAR), F.MISC + 8);
#define IN(k) (lo <= (k) && (k) < hi)
#define SEAM(k) do { if (IN(k) && IN((k) + 1)) xcd_barrier(bar); } while (0)
    unsigned char* ws = args.ws;
    bf16* H = (bf16*)(ws + WS_H);
    const float* ada = (const float*)(ws + WS_ADA);

#ifndef NOP0
    if (IN(0)) { p0_prologue(F); } SEAM(0);
#else
    SEAM(0);
#endif
#ifndef NOP1
    if (IN(1)) { norm_mod_phase(F, F.x, F.ng + 0 * DM, 0, 0); } SEAM(1);
#else
    SEAM(1);
#endif
    if (IN(2)) {
        pg8::Gemm g{H, (const bf16*)(ws + WS_WQKV), MT, NQKV, DM}; pg8::StaticOrder S; S.init(MT, NQKV, F.G, (int)blockIdx.x);
        pg8::EpiBf16<0> E{(bf16*)(ws + WS_Q), DM, nullptr, DM, (size_t)(WS_K - WS_Q) / 2, 1.0f};
        pg8::gemm_phase<pg8::EpiBf16<0>, pg8::StaticOrder, true, true>(F.lds + RING_OFF, g, S, E);
    } SEAM(2);
#ifndef NOP3
    if (IN(3)) { rope_att_phase(F); } SEAM(3);
#else
    SEAM(3);
#endif
#ifndef NOP4
    if (IN(4)) { kmean_phase(F); } SEAM(4);
#else
    SEAM(4);
#endif
#ifndef NOP5
    if (IN(5)) { attn_naive_phase(F); } SEAM(5);
#else
    SEAM(5);
#endif
    if (IN(6)) {
        pg8::Gemm g{(const bf16*)(ws + WS_Q), (const bf16*)(ws + WS_WO), MT, DM, DM}; pg8::StaticOrder S; S.init(MT, DM, F.G, (int)blockIdx.x);
        pg8::EpiRes E{F.x, F.out, ada + 2 * 1024};
        pg8::gemm_phase<pg8::EpiRes, pg8::StaticOrder, false, true>(F.lds + RING_OFF, g, S, E);
    } SEAM(6);
#ifndef NOP7
    if (IN(7)) { norm_mod_phase(F, F.out, F.ng + 1 * DM, 0, 3); } SEAM(7);
#else
    SEAM(7);
#endif
    if (IN(8)) {
        pg8::Gemm g{H, (const bf16*)(ws + WS_GU0), MT, NGU, DM}; pg8::StaticOrder S; S.init(MT, NGU, F.G, (int)blockIdx.x);
        pg8::EpiSwiglu E{(bf16*)(ws + WS_HMID0)};
        pg8::gemm_phase<pg8::EpiSwiglu, pg8::StaticOrder, true, true>(F.lds + RING_OFF, g, S, E);
    } SEAM(8);
    if (IN(9)) {
        pg8::Gemm g{(const bf16*)(ws + WS_HMID0), (const bf16*)(ws + WS_D0), MT, DM, DFF}; pg8::StaticOrder S; S.init(MT, DM, F.G, (int)blockIdx.x);
        pg8::EpiRes E{F.out, F.out, ada + 5 * 1024};
        pg8::gemm_phase<pg8::EpiRes, pg8::StaticOrder, false, true>(F.lds + RING_OFF, g, S, E);
    } SEAM(9);
#ifndef NOP10
    if (IN(10)) { norm_mod_phase(F, F.out, F.ng + 2 * DM, 1, 0); } SEAM(10);
#else
    SEAM(10);
#endif
    if (IN(11)) {
        pg8::Gemm g{H, (const bf16*)(ws + WS_WIN), MT, NRIN, DM}; pg8::StaticOrder S; S.init(MT, NRIN, F.G, (int)blockIdx.x);
        pg8::EpiWin E{(bf16*)(ws + WS_QR), (bf16*)(ws + WS_KR), (bf16*)(ws + WS_VR), (bf16*)(ws + WS_GR)};
        pg8::gemm_phase<pg8::EpiWin, pg8::StaticOrder, true, true>(F.lds + RING_OFF, g, S, E);
    } SEAM(11);
#ifndef NOP12
    if (IN(12)) { rope_ret_phase(F); convert_set_b(F); } SEAM(12);
#else
    SEAM(12);
#endif
#ifndef NOP13
    if (IN(13)) { ret_naive_phase(F); } SEAM(13);
#else
    SEAM(13);
#endif
#ifndef NOP14
    if (IN(14)) { gn_gate_phase(F); } SEAM(14);
#else
    SEAM(14);
#endif
    if (IN(15)) {
        pg8::Gemm g{(const bf16*)(ws + WS_VR), (const bf16*)(ws + WS_WRO), MT, DM, RV}; pg8::StaticOrder S; S.init(MT, DM, F.G, (int)blockIdx.x);
        pg8::EpiRes E{F.out, F.out, ada + 4 * 6144 + 2 * 1024};
        pg8::gemm_phase<pg8::EpiRes, pg8::StaticOrder, false, true>(F.lds + RING_OFF, g, S, E);
    } SEAM(15);
#ifndef NOP16
    if (IN(16)) { norm_mod_phase(F, F.out, F.ng + 3 * DM, 1, 3); } SEAM(16);
#else
    SEAM(16);
#endif
    if (IN(17)) {
        pg8::Gemm g{H, (const bf16*)(ws + WS_GU1), MT, NGU, DM}; pg8::StaticOrder S; S.init(MT, NGU, F.G, (int)blockIdx.x);
        pg8::EpiSwiglu E{(bf16*)(ws + WS_HMID1)};
        pg8::gemm_phase<pg8::EpiSwiglu, pg8::StaticOrder, true, true>(F.lds + RING_OFF, g, S, E);
    } SEAM(17);
    if (IN(18)) {
        pg8::Gemm g{(const bf16*)(ws + WS_HMID1), (const bf16*)(ws + WS_D1), MT, DM, DFF}; pg8::StaticOrder S; S.init(MT, DM, F.G, (int)blockIdx.x);
        pg8::EpiRes E{F.out, F.out, ada + 4 * 6144 + 5 * 1024};
        pg8::gemm_phase<pg8::EpiRes, pg8::StaticOrder, false, true>(F.lds + RING_OFF, g, S, E);
    } SEAM(18);
#ifndef NOP19
    if (IN(19)) { final_norm_phase(F); }
#else

#endif
#undef IN
#undef SEAM
}

extern "C" void kernel_launch(void* const* d_in, const int* in_sizes, int n_in, void* d_out, int out_size, void* d_ws, size_t ws_size, hipStream_t stream) {
    static int grid = 0;
    if (grid == 0) {
        if (n_in != 13 || out_size != MT * DM || ws_size < WS_END) { fprintf(stderr, "kernel_launch: unexpected shapes (n_in %d out %d ws %zu)\n", n_in, out_size, ws_size); grid = -1; return; }
        int dev = 0, cus = 0;
        if (hipGetDevice(&dev) != hipSuccess || hipDeviceGetAttribute(&cus, hipDeviceAttributeMultiprocessorCount, dev) != hipSuccess) { grid = -1; return; }
        if (hipFuncSetAttribute((const void*)mk_fwd, hipFuncAttributeMaxDynamicSharedMemorySize, LDS_BYTES) != hipSuccess) { fprintf(stderr, "kernel_launch: hipFuncSetAttribute failed\n"); grid = -1; return; }
        int per_cu = 0;
        if (hipOccupancyMaxActiveBlocksPerMultiprocessor(&per_cu, (const void*)mk_fwd, NWAVES * 64, LDS_BYTES) != hipSuccess || per_cu < 1) fprintf(stderr, "kernel_launch: occupancy query says %d\n", per_cu);
        (void)hipGetLastError();
        grid = cus;
    }
    if (grid < 0) return;
    if (hipMemsetAsync((char*)d_ws + WS_CTL, 0, CTL_ZERO_BYTES, stream) != hipSuccess) return;
    Args a{};
    for (int i = 0; i < 13; ++i) a.in[i] = (const float*)d_in[i];
    a.out = (float*)d_out; a.ws = (unsigned char*)d_ws;
    const int NL = MK_N_LAUNCHES;
    for (int li = 0; li < NL; ++li) {
        a.ph_lo = (NL == 1) ? 0 : li; a.ph_hi = (NL == 1) ? NPH : li + 1; a.li = li;
        hipLaunchKernelGGL(mk_fwd, dim3(grid), dim3(NWAVES * 64), LDS_BYTES, stream, a);
    }
}
```

```cpp
#include <hip/hip_runtime.h>
#include <cstdio>
#include <cstdint>
#include <cmath>
__device__ const double INV64[32] = {
1, 0.74989420933245587, 0.56234132519034907, 0.42169650342858223,
0.31622776601683794, 0.23713737056616552, 0.17782794100389229, 0.1333521432163324,
0.10000000000000001, 0.074989420933245579, 0.056234132519034911, 0.042169650342858224,
0.031622776601683791, 0.023713737056616554, 0.017782794100389229, 0.013335214321633241,
0.01, 0.0074989420933245579, 0.005623413251903491, 0.0042169650342858229,
0.0031622776601683794, 0.0023713737056616554, 0.0017782794100389228, 0.0013335214321633241,
0.001, 0.00074989420933245586, 0.0005623413251903491, 0.00042169650342858224,
0.00031622776601683794, 0.00023713737056616554, 0.00017782794100389227, 0.0001333521432163324,
};
__device__ const double INV256[128] = {
1, 0.93057204092969903, 0.86596432336006535, 0.80584218776148187,
0.74989420933245587, 0.69783058485986638, 0.64938163157621132, 0.60429639023813286,
0.56234132519034907, 0.5232991146814947, 0.48696752516586311, 0.45315836376008178,
0.42169650342858223, 0.39241897584845359, 0.36517412725483772, 0.33982083289425596,
0.31622776601683794, 0.29427271762092816, 0.27384196342643613, 0.25482967479793467,
0.23713737056616552, 0.22067340690845899, 0.20535250264571461, 0.19109529749704404,
0.17782794100389229, 0.16548170999431813, 0.15399265260594919, 0.14330125702369628,
0.1333521432163324, 0.12409377607517195, 0.11547819846894582, 0.10746078283213174,
0.10000000000000001, 0.0930572040929699, 0.086596432336006529, 0.080584218776148187,
0.074989420933245579, 0.069783058485986635, 0.064938163157621132, 0.060429639023813285,
0.056234132519034911, 0.05232991146814947, 0.048696752516586311, 0.045315836376008181,
0.042169650342858224, 0.039241897584845357, 0.036517412725483769, 0.033982083289425591,
0.031622776601683791, 0.029427271762092817, 0.027384196342643614, 0.025482967479793464,
0.023713737056616554, 0.022067340690845899, 0.02053525026457146, 0.019109529749704406,
0.017782794100389229, 0.016548170999431813, 0.015399265260594919, 0.014330125702369627,
0.013335214321633241, 0.012409377607517195, 0.011547819846894581, 0.010746078283213174,
0.01, 0.0093057204092969904, 0.0086596432336006543, 0.008058421877614819,
0.0074989420933245579, 0.0069783058485986633, 0.006493816315762113, 0.0060429639023813278,
0.005623413251903491, 0.0052329911468149467, 0.004869675251658631, 0.0045315836376008181,
0.0042169650342858229, 0.0039241897584845363, 0.0036517412725483771, 0.0033982083289425592,
0.0031622776601683794, 0.002942727176209282, 0.0027384196342643613, 0.0025482967479793467,
0.0023713737056616554, 0.0022067340690845897, 0.002053525026457146, 0.0019109529749704406,
0.0017782794100389228, 0.0016548170999431814, 0.001539926526059492, 0.0014330125702369627,
0.0013335214321633241, 0.0012409377607517195, 0.0011547819846894581, 0.0010746078283213176,
0.001, 0.00093057204092969893, 0.00086596432336006539, 0.00080584218776148179,
0.00074989420933245586, 0.00069783058485986635, 0.00064938163157621134, 0.00060429639023813287,
0.0005623413251903491, 0.00052329911468149473, 0.0004869675251658631, 0.00045315836376008179,
0.00042169650342858224, 0.00039241897584845359, 0.0003651741272548377, 0.00033982083289425596,
0.00031622776601683794, 0.00029427271762092817, 0.00027384196342643611, 0.00025482967479793463,
0.00023713737056616554, 0.00022067340690845897, 0.00020535250264571461, 0.00019109529749704405,
0.00017782794100389227, 0.00016548170999431815, 0.00015399265260594919, 0.00014330125702369627,
0.0001333521432163324, 0.00012409377607517196, 0.00011547819846894582, 0.00010746078283213175,
};
namespace pg8 {
#define PG8_LAS __attribute__((address_space(3)))
typedef unsigned short bf16_t;
typedef short bf16x8 __attribute__((ext_vector_type(8)));
typedef float f32x4 __attribute__((ext_vector_type(4)));
typedef unsigned u32x4 __attribute__((ext_vector_type(4)));
constexpr int BM = 256, BK = 64, HALF = 128, HTB = HALF * BK * 2  , STAGE_BYTES = 8 * HTB, NXCD = 8, WGM = 8;

__host__ __device__ __forceinline__ int lds_byte(int r, int c) { const int st = (r >> 4) * 2 + (c >> 5), rr = r & 15, cc = c & 31, ob = rr * 64 + cc * 2; return st * 1024 + (ob ^ (((ob >> 9) & 1) << 5)); }
__host__ __device__ __forceinline__ void stage_rc(int b, int& R, int& C) { const int st = b / 1024, sb = b % 1024, swz = sb ^ (((sb >> 9) & 1) << 5); R = (st >> 1) * 16 + swz / 64; C = (st & 1) * 32 + (swz % 64) / 2; }
__host__ __device__ __forceinline__ int perm32(int rho) { const int n = rho >> 4, i = rho & 15; return 8 * (i >> 2) + 4 * n + (i & 3); }

struct Unit { int pm, pn; };
struct Gemm { const bf16_t* A; const bf16_t* Bt; int M, N, K; };

struct StaticOrder {
    int nM, nN, nwg, G, c;
    __host__ __device__ void init(int M, int N, int G_, int c_) { nM = M / BM; nN = N / BM; nwg = nM * nN; G = G_; c = c_; }
    __host__ __device__ bool next(int i, Unit& u) const {
        const long L = (long)i * G + c; if (L >= nwg) return false;
        int wgid = (int)L; { const int q = nwg / NXCD, r = nwg % NXCD, xcd = wgid % NXCD, off = wgid / NXCD; wgid = (xcd < r ? xcd * (q + 1) : r * (q + 1) + (xcd - r) * q) + off; }
        const int nig = WGM * nN, gid = wgid / nig, fm = gid * WGM, gsz = (nM - fm) < WGM ? (nM - fm) : WGM;
        u.pm = fm + ((wgid % nig) % gsz); u.pn = (wgid % nig) / gsz; return true;
    }
    __device__ __forceinline__ void a_ready(const Unit&) const {}
    __device__ __forceinline__ void done(const Unit&) const {}
};

__device__ __forceinline__ unsigned cvt_pk_bf16(float lo, float hi) { unsigned r; asm volatile("v_cvt_pk_bf16_f32 %0, %1, %2" : "=v"(r) : "v"(lo), "v"(hi)); return r; }
typedef float f32x2 __attribute__((ext_vector_type(2)));
__device__ __forceinline__ f32x2 gelu_pk(f32x2 v) {
    const f32x2 av = __builtin_elementwise_abs(v), d = av * 0.2316418882f + 1.0f;
    f32x2 t; t.x = __builtin_amdgcn_rcpf(d.x); t.y = __builtin_amdgcn_rcpf(d.y);
    f32x2 q = t * 0.5307027145f + (-0.7265760135f); q = q * t + 0.7107068705f; q = q * t + (-0.142248368f); q = q * t + 0.127414796f; q = q * t;
    const f32x2 s = (v * v) * (-0.72134752044f);
    f32x2 e; e.x = __builtin_amdgcn_exp2f(s.x); e.y = __builtin_amdgcn_exp2f(s.y);
    const f32x2 m = v * (q * e), r = v - m;
    f32x2 o; o.x = v.x < 0.f ? m.x : r.x; o.y = v.y < 0.f ? m.y : r.y; return o;
}

template <int ACT  > struct EpiBf16 {
    static constexpr bool PERM = true, AFTER_DRAIN = false; static_assert(ACT == 0 || ACT == 1, "EpiBf16: ACT is 0 (none) or 1 (gelu_pk)");
    bf16_t* O; int ldc; const float* bias; int split_cols; size_t split_stride; float scale0;
    __device__ __forceinline__ void operator()(const f32x4 (&acc)[2][2][4][2], const Unit& u, int wr, int wc, int fr, int fq) const {
        const int row0 = u.pm * BM + wr * 64 + fr; int colt = u.pn * BM; bf16_t* base = O;
        float sc = 1.f; if (split_cols) { const int t = colt / split_cols; base += (size_t)t * split_stride; colt -= t * split_cols; if (t == 0) sc = scale0; }
        const int col0 = colt + wc * 32 + 8 * fq, bcol0 = u.pn * BM + wc * 32 + 8 * fq;
        f32x4 bv[2][2];
#pragma unroll
        for (int bj = 0; bj < 2; ++bj)
#pragma unroll
            for (int n = 0; n < 2; ++n) bv[bj][n] = bias ? *(const f32x4*)(bias + bcol0 + bj * HALF + 4 * n) : (f32x4){0.f, 0.f, 0.f, 0.f};
#pragma unroll
        for (int ai = 0; ai < 2; ++ai)
#pragma unroll
            for (int m = 0; m < 4; ++m) { bf16_t* rowp = base + (size_t)(row0 + ai * HALF + m * 16) * ldc + col0;
#pragma unroll
                for (int bj = 0; bj < 2; ++bj) { f32x4 v0 = acc[ai][bj][m][0] + bv[bj][0], v1 = acc[ai][bj][m][1] + bv[bj][1];
                    if (ACT == 1) { f32x2 a = gelu_pk((f32x2){v0[0], v0[1]}), b = gelu_pk((f32x2){v0[2], v0[3]}), c = gelu_pk((f32x2){v1[0], v1[1]}), d = gelu_pk((f32x2){v1[2], v1[3]});
                        v0 = (f32x4){a.x, a.y, b.x, b.y}; v1 = (f32x4){c.x, c.y, d.x, d.y}; }
                    v0 = v0 * sc; v1 = v1 * sc; u32x4 w; w.x = cvt_pk_bf16(v0[0], v0[1]); w.y = cvt_pk_bf16(v0[2], v0[3]); w.z = cvt_pk_bf16(v1[0], v1[1]); w.w = cvt_pk_bf16(v1[2], v1[3]);
                    *(u32x4*)(rowp + bj * HALF) = w; } }
    }
};

struct PanelStats {
    unsigned* xbuf;
    unsigned* cnt;
    unsigned* tmo;
    int ntn; float eps;
    unsigned code;
    __device__ __forceinline__ bool run(const f32x4 (&v)[2][2][4][2], const Unit& u, int wr, int wc, int fr, int fq, PG8_LAS unsigned char* lds, int wid, int lane) const {
        typedef float f32x2v __attribute__((ext_vector_type(2)));
        PG8_LAS f32x2v* P = (PG8_LAS f32x2v*)lds;
        PG8_LAS f32x2v* S = (PG8_LAS f32x2v*)(lds + 8192);
        PG8_LAS unsigned* flag = (PG8_LAS unsigned*)(lds + 8192 + 2048);
#pragma unroll
        for (int ai = 0; ai < 2; ++ai)
#pragma unroll
            for (int m = 0; m < 4; ++m) {
                float s = 0.f;
#pragma unroll
                for (int bj = 0; bj < 2; ++bj)
#pragma unroll
                    for (int n = 0; n < 2; ++n) { const f32x4 x = v[ai][bj][m][n]; s += (x[0] + x[1]) + (x[2] + x[3]); }
                s += __shfl_xor(s, 16); s += __shfl_xor(s, 32);
                const float mw = s * (1.0f / 64.0f); float q = 0.f;
#pragma unroll
                for (int bj = 0; bj < 2; ++bj)
#pragma unroll
                    for (int n = 0; n < 2; ++n) { const f32x4 d = v[ai][bj][m][n] - mw; q += (d[0] * d[0] + d[1] * d[1]) + (d[2] * d[2] + d[3] * d[3]); }
                q += __shfl_xor(q, 16); q += __shfl_xor(q, 32);
                if (fq == 0) P[(ai * HALF + wr * 64 + m * 16 + fr) * 4 + wc] = (f32x2v){mw, q};
            }
        asm volatile("s_waitcnt lgkmcnt(0)" ::: "memory"); __builtin_amdgcn_s_barrier(); asm volatile("" ::: "memory");
#if defined(BROKEN_EXCHANGE_NO_WAIT)
#warning BROKEN CONTROL BUILD: the row-statistics exchange does not wait; results are wrong by design
        if (blockIdx.x >= 64) { const long long t0_ = clock64(); while (clock64() - t0_ < 60000) __builtin_amdgcn_s_sleep(8); }
#endif
        const int row = wid * 32 + (lane & 31);
        if (lane < 32) {
            const f32x2v a = P[row * 4 + 0], b = P[row * 4 + 1], c = P[row * 4 + 2], d = P[row * 4 + 3];
            const float mt = (a.x + b.x + c.x + d.x) * 0.25f;
            const float da = a.x - mt, db = b.x - mt, dc = c.x - mt, dd = d.x - mt;
            const float m2 = (a.y + b.y) + (c.y + d.y) + 64.0f * ((da * da + db * db) + (dc * dc + dd * dd));
            unsigned long long* slot = (unsigned long long*)xbuf + ((size_t)(u.pm * BM + row) * 4 + u.pn);
            __hip_atomic_store(slot, ((unsigned long long)__float_as_uint(m2) << 32) | __float_as_uint(mt), __ATOMIC_RELAXED, __HIP_MEMORY_SCOPE_AGENT);
        }
        asm volatile("s_waitcnt vmcnt(0)" ::: "memory");
        if (lane == 0) __hip_atomic_fetch_add(cnt + 64 * u.pm, 1u, __ATOMIC_RELAXED, __HIP_MEMORY_SCOPE_AGENT);
        if (wid == 0) {
            bool dead = false; const unsigned long long t0 = __builtin_amdgcn_s_memrealtime(); const unsigned want = 8u * (unsigned)ntn;
            for (;;) {
#if defined(BROKEN_EXCHANGE_NO_WAIT)
                break;
#endif
                if ((unsigned)__builtin_amdgcn_readfirstlane(__hip_atomic_load(cnt + 64 * u.pm, __ATOMIC_RELAXED, __HIP_MEMORY_SCOPE_AGENT)) >= want) break;
                if (__builtin_amdgcn_s_memrealtime() - t0 > 2000000ull) {
                    if (lane == 0) { unsigned expect = 0u; __hip_atomic_compare_exchange_strong(tmo + 1, &expect, code | (unsigned)(u.pm & 0xff), __ATOMIC_RELAXED, __ATOMIC_RELAXED, __HIP_MEMORY_SCOPE_AGENT);
                                     __hip_atomic_store(tmo, 1u, __ATOMIC_RELAXED, __HIP_MEMORY_SCOPE_AGENT); }
                    dead = true; break; }
                __builtin_amdgcn_s_sleep(2);
            }
            __builtin_amdgcn_fence(__ATOMIC_ACQUIRE, "agent");
            if (lane == 0) flag[0] = dead ? 1u : 0u;
        }
        asm volatile("s_waitcnt vmcnt(0) lgkmcnt(0)" ::: "memory"); __builtin_amdgcn_s_barrier(); asm volatile("" ::: "memory");
        const bool bad = flag[0] != 0u;
        if (lane < 32) {
            const unsigned long long* slot = (const unsigned long long*)xbuf + (size_t)(u.pm * BM + row) * 4; float mt[4], m2[4]; float ms = 0.f;
#pragma unroll
            for (int t = 0; t < 4; ++t) { if (t < ntn) { const unsigned long long w = __hip_atomic_load(slot + t, __ATOMIC_RELAXED, __HIP_MEMORY_SCOPE_AGENT); mt[t] = __uint_as_float((unsigned)w); m2[t] = __uint_as_float((unsigned)(w >> 32)); } else { mt[t] = 0.f; m2[t] = 0.f; } ms += mt[t]; }
            const float mean = ms / (float)ntn; float q = 0.f;
#pragma unroll
            for (int t = 0; t < 4; ++t) if (t < ntn) { const float dm = mt[t] - mean; q += m2[t] + 256.0f * dm * dm; }
            S[row] = (f32x2v){mean, 1.0f / sqrtf(q / (256.0f * (float)ntn) + eps)};
        }
        asm volatile("s_waitcnt lgkmcnt(0)" ::: "memory"); __builtin_amdgcn_s_barrier(); asm volatile("" ::: "memory");
        return bad;
    }
};
struct EpiLnRes {
    static constexpr bool PERM = false, AFTER_DRAIN = true;
    const float* base; float* out; int ldc; const float* bias; PanelStats st; unsigned poison;
    __device__ __forceinline__ void fused(f32x4 (&acc)[2][2][4][2], const Unit& u, int wr, int wc, int fr, int fq, PG8_LAS unsigned char* lds, int wid, int lane) const {
        typedef float f32x2v __attribute__((ext_vector_type(2)));
        const PG8_LAS f32x2v* S = (const PG8_LAS f32x2v*)(lds + 8192);
        const int col0 = u.pn * BM + wc * 32 + 4 * fq;
#pragma unroll
        for (int bj = 0; bj < 2; ++bj)
#pragma unroll
            for (int n = 0; n < 2; ++n) { const f32x4 bv = bias ? *(const f32x4*)(bias + col0 + bj * HALF + n * 16) : (f32x4){0.f, 0.f, 0.f, 0.f};
#pragma unroll
                for (int ai = 0; ai < 2; ++ai)
#pragma unroll
                    for (int m = 0; m < 4; ++m) acc[ai][bj][m][n] += bv; }
        f32x4 pre[4][2][2];
#pragma unroll
        for (int m = 0; m < 4; ++m) { const size_t off = (size_t)(u.pm * BM + wr * 64 + m * 16 + fr) * ldc + col0;
#pragma unroll
            for (int bj = 0; bj < 2; ++bj)
#pragma unroll
                for (int n = 0; n < 2; ++n) pre[m][bj][n] = *(const f32x4*)(base + off + bj * HALF + n * 16); }
        const bool bad = st.run(acc, u, wr, wc, fr, fq, lds, wid, lane) || poison != 0u;
        const float qnan = __builtin_nanf("");
#pragma unroll
        for (int ai = 0; ai < 2; ++ai)
#pragma unroll
            for (int m = 0; m < 4; ++m) { const int r = ai * HALF + wr * 64 + m * 16 + fr; const f32x2v sr = S[r]; const size_t off = (size_t)(u.pm * BM + r) * ldc + col0;
#pragma unroll
                for (int bj = 0; bj < 2; ++bj)
#pragma unroll
                    for (int n = 0; n < 2; ++n) { const f32x4 bs = ai == 0 ? pre[m][bj][n] : *(const f32x4*)(base + off + bj * HALF + n * 16); f32x4 o = bs + (acc[ai][bj][m][n] - sr.x) * sr.y;
                        if (bad) o = (f32x4){qnan, qnan, qnan, qnan}; *(f32x4*)(out + off + bj * HALF + n * 16) = o; }
                if (m & 1) asm volatile("" ::: "memory"); }
    }
};
struct EpiLnResLn {
    static constexpr bool PERM = false, AFTER_DRAIN = true;
    const float* base; float* out; bf16_t* xn; int ldc; const float* bias; PanelStats st1, st2; unsigned poison;
    __device__ __forceinline__ void fused(f32x4 (&acc)[2][2][4][2], const Unit& u, int wr, int wc, int fr, int fq, PG8_LAS unsigned char* lds, int wid, int lane) const {
        typedef float f32x2v __attribute__((ext_vector_type(2))); typedef unsigned u32x2v __attribute__((ext_vector_type(2)));
        const PG8_LAS f32x2v* S = (const PG8_LAS f32x2v*)(lds + 8192);
        const int col0 = u.pn * BM + wc * 32 + 4 * fq;
#pragma unroll
        for (int bj = 0; bj < 2; ++bj)
#pragma unroll
            for (int n = 0; n < 2; ++n) { const f32x4 bv = bias ? *(const f32x4*)(bias + col0 + bj * HALF + n * 16) : (f32x4){0.f, 0.f, 0.f, 0.f};
#pragma unroll
                for (int ai = 0; ai < 2; ++ai)
#pragma unroll
                    for (int m = 0; m < 4; ++m) acc[ai][bj][m][n] += bv; }
        bool bad = st1.run(acc, u, wr, wc, fr, fq, lds, wid, lane) || poison != 0u;
        const float qnan = __builtin_nanf("");
#pragma unroll
        for (int ai = 0; ai < 2; ++ai)
#pragma unroll
            for (int m = 0; m < 4; ++m) { const int r = ai * HALF + wr * 64 + m * 16 + fr; const f32x2v sr = S[r]; const size_t off = (size_t)(u.pm * BM + r) * ldc + col0;
#pragma unroll
                for (int bj = 0; bj < 2; ++bj)
#pragma unroll
                    for (int n = 0; n < 2; ++n) { const f32x4 bs = *(const f32x4*)(base + off + bj * HALF + n * 16); acc[ai][bj][m][n] = bs + (acc[ai][bj][m][n] - sr.x) * sr.y; }
                asm volatile("" : "+v"(acc[ai][0][m][0]), "+v"(acc[ai][0][m][1]), "+v"(acc[ai][1][m][0]), "+v"(acc[ai][1][m][1]));
                if (m & 1) asm volatile("" ::: "memory"); }
        const bool bad1 = bad;
        bad = st2.run(acc, u, wr, wc, fr, fq, lds, wid, lane) || bad;
#pragma unroll
        for (int ai = 0; ai < 2; ++ai)
#pragma unroll
            for (int m = 0; m < 4; ++m) { const int r = ai * HALF + wr * 64 + m * 16 + fr; const f32x2v sr = S[r]; const size_t off = (size_t)(u.pm * BM + r) * ldc + col0;
#pragma unroll
                for (int bj = 0; bj < 2; ++bj)
#pragma unroll
                    for (int n = 0; n < 2; ++n) { const f32x4 x1 = acc[ai][bj][m][n]; *(f32x4*)(out + off + bj * HALF + n * 16) = bad1 ? (f32x4){qnan, qnan, qnan, qnan} : x1;
                        const f32x4 o = (x1 - sr.x) * sr.y; u32x2v w; w.x = cvt_pk_bf16(o[0], o[1]); w.y = cvt_pk_bf16(o[2], o[3]);
                        if (bad) { w.x = 0x7fc07fc0u; w.y = 0x7fc07fc0u; } *(u32x2v*)(xn + off + bj * HALF + n * 16) = w; }
                asm volatile("" ::: "memory"); }
    }
};

template <class Epi, class Sched, bool ALIGN_EPI = false, bool SP2 = false>
__device__ __forceinline__ void gemm_phase(PG8_LAS unsigned char* lds, const Gemm g, const Sched& S, const Epi& E) {
    const int tid = threadIdx.x, wid = __builtin_amdgcn_readfirstlane(tid >> 6), lane = tid & 63, wr = wid >> 2, wc = wid & 3, fr = lane & 15, fq = lane >> 4;
    const int K = g.K, nt = K / BK;
    unsigned voffA[2], voffB[2];
#pragma unroll
    for (int i = 0; i < 2; ++i) { int R, C; stage_rc(tid * 16 + i * 8192, R, C); const int Rb = Epi::PERM ? ((R & ~31) + perm32(R & 31)) : R;
        voffA[i] = (unsigned)(R * K + C) * 2u; voffB[i] = (unsigned)(Rb * K + C) * 2u; }
    const size_t kstep = (size_t)(BK * 2);
    const size_t hstep = (size_t)HALF * K * 2;
    const size_t tstep = 2 * hstep;
    const unsigned ldsw = (unsigned)wid * 1024u;
    const int aoff = lds_byte(wr * 64 + fr, fq * 8), boff = lds_byte(wc * 32 + fr, fq * 8);
#define PG8_SA(b, h) (((b) * 2 + (h)) * HTB)
#define PG8_SB(b, h) ((4 + (b) * 2 + (h)) * HTB)
#define PG8_STAGE(bufoff, gbase, voff) do { _Pragma("unroll") for (int _i = 0; _i < 2; ++_i) \
        __builtin_amdgcn_global_load_lds((const unsigned*)((const char*)(gbase) + (voff)[_i]), (PG8_LAS unsigned*)(lds + (bufoff) + ldsw + _i * 8192), 16, 0, 0); } while (0)
#define PG8_LDA(dst, b, h) do { _Pragma("unroll") for (int m = 0; m < 4; ++m) _Pragma("unroll") for (int k = 0; k < 2; ++k) dst[m][k] = *(const PG8_LAS bf16x8*)(lds + PG8_SA(b, h) + aoff + m * 2048 + k * 1024); } while (0)
#define PG8_LDB(dst, b, h) do { _Pragma("unroll") for (int n = 0; n < 2; ++n) _Pragma("unroll") for (int k = 0; k < 2; ++k) dst[n][k] = *(const PG8_LAS bf16x8*)(lds + PG8_SB(b, h) + boff + n * 2048 + k * 1024); } while (0)
#define PG8_MMA(ai, bj, At, Bt) do { __builtin_amdgcn_s_setprio(1); _Pragma("unroll") for (int m = 0; m < 4; ++m) _Pragma("unroll") for (int n = 0; n < 2; ++n) _Pragma("unroll") for (int k = 0; k < 2; ++k) \
        acc[ai][bj][m][n] = __builtin_amdgcn_mfma_f32_16x16x32_bf16(Bt[n][k], At[m][k], acc[ai][bj][m][n], 0, 0, 0); __builtin_amdgcn_s_setprio(0); } while (0)
#define PG8_WAIT_V(n) asm volatile("s_waitcnt vmcnt(" #n ")" ::: "memory")
#define PG8_WAIT_L(n) asm volatile("s_waitcnt lgkmcnt(" #n ")" ::: "memory")
#define PG8_BAR __builtin_amdgcn_s_barrier()
#define PG8_SCHED __builtin_amdgcn_sched_barrier(0)
    Unit cur, nxt; int ui = 0;
    if (!S.next(0, cur)) return;
    f32x4 acc[2][2][4][2];
#pragma unroll
    for (int a = 0; a < 2; ++a)
#pragma unroll
        for (int b = 0; b < 2; ++b)
#pragma unroll
            for (int m = 0; m < 4; ++m)
#pragma unroll
                for (int n = 0; n < 2; ++n) acc[a][b][m][n] = (f32x4){0.f, 0.f, 0.f, 0.f};
    bf16x8 At[4][2], B0[2][2], B1[2][2];
    const char* cA = (const char*)g.A + (size_t)cur.pm * tstep; const char* cB = (const char*)g.Bt + (size_t)cur.pn * tstep;
    S.a_ready(cur);
    if constexpr (SP2) {
        PG8_STAGE(PG8_SB(0, 0), cB, voffB); PG8_STAGE(PG8_SB(0, 1), cB + hstep, voffB); PG8_STAGE(PG8_SA(0, 0), cA, voffA); PG8_STAGE(PG8_SA(0, 1), cA + hstep, voffA);
        if (wr == 1) PG8_BAR;
        PG8_WAIT_V(2); PG8_BAR;
        PG8_STAGE(PG8_SB(1, 0), cB + kstep, voffB); PG8_STAGE(PG8_SA(1, 0), cA + kstep, voffA); PG8_STAGE(PG8_SB(1, 1), cB + hstep + kstep, voffB);
        PG8_WAIT_V(6); PG8_BAR;
    } else {
        PG8_STAGE(PG8_SB(0, 0), cB, voffB); PG8_STAGE(PG8_SA(0, 0), cA, voffA); PG8_STAGE(PG8_SB(0, 1), cB + hstep, voffB); PG8_STAGE(PG8_SA(0, 1), cA + hstep, voffA);
        if (wr == 1) PG8_BAR;
        PG8_WAIT_V(4); PG8_BAR;
        PG8_STAGE(PG8_SB(1, 0), cB + kstep, voffB); PG8_STAGE(PG8_SA(1, 0), cA + kstep, voffA); PG8_STAGE(PG8_SB(1, 1), cB + hstep + kstep, voffB);
        PG8_WAIT_V(6); PG8_BAR;
    }
    for (;;) {
        const bool has_next = S.next(ui + 1, nxt);
        const char* nA = has_next ? (const char*)g.A + (size_t)nxt.pm * tstep : cA; const char* nB = has_next ? (const char*)g.Bt + (size_t)nxt.pn * tstep : cB;
        for (int t = 0; t < nt; t += 2) {
            const bool last = (t == nt - 2);
            const char* a1 = cA + (size_t)(t + 1) * kstep;
            const char* a2 = last ? nA : cA + (size_t)(t + 2) * kstep; const char* b2 = last ? nB : cB + (size_t)(t + 2) * kstep;
            const char* a3 = a2 + kstep; const char* b3 = b2 + kstep;
            if (last && has_next) S.a_ready(nxt);
            if constexpr (SP2) {
            PG8_LDB(B0, 0, 0); PG8_LDB(B1, 0, 1); PG8_SCHED; PG8_LDA(At, 0, 0); PG8_STAGE(PG8_SA(1, 1), a1 + hstep, voffA);
            PG8_WAIT_V(8); PG8_WAIT_L(0); PG8_BAR; PG8_MMA(0, 0, At, B0); PG8_MMA(0, 1, At, B1); PG8_BAR; PG8_SCHED;
            PG8_LDA(At, 0, 1); PG8_STAGE(PG8_SB(0, 0), b2, voffB); PG8_STAGE(PG8_SB(0, 1), b2 + hstep, voffB); PG8_STAGE(PG8_SA(0, 0), a2, voffA);
            PG8_WAIT_V(8); PG8_WAIT_L(0); PG8_BAR; PG8_MMA(1, 0, At, B0); PG8_MMA(1, 1, At, B1); PG8_BAR; PG8_SCHED;
            PG8_LDB(B0, 1, 0); PG8_LDB(B1, 1, 1); PG8_SCHED; PG8_LDA(At, 1, 0); PG8_STAGE(PG8_SA(0, 1), a2 + hstep, voffA);
            PG8_WAIT_V(8); PG8_WAIT_L(0); PG8_BAR; PG8_MMA(0, 0, At, B0); PG8_MMA(0, 1, At, B1); PG8_BAR; PG8_SCHED;
            PG8_LDA(At, 1, 1); PG8_STAGE(PG8_SB(1, 0), b3, voffB); PG8_STAGE(PG8_SB(1, 1), b3 + hstep, voffB); PG8_STAGE(PG8_SA(1, 0), a3, voffA);
            PG8_WAIT_V(8); PG8_WAIT_L(0); PG8_BAR; PG8_MMA(1, 0, At, B0); PG8_MMA(1, 1, At, B1); PG8_BAR; PG8_SCHED;
            } else {
            PG8_LDB(B0, 0, 0); PG8_SCHED; PG8_LDA(At, 0, 0); PG8_STAGE(PG8_SA(1, 1), a1 + hstep, voffA);
            PG8_WAIT_L(8); PG8_BAR; PG8_WAIT_L(0); PG8_MMA(0, 0, At, B0); PG8_BAR; PG8_SCHED;
            PG8_LDB(B1, 0, 1); PG8_STAGE(PG8_SB(0, 0), b2, voffB);
            PG8_BAR; PG8_WAIT_L(0); PG8_MMA(0, 1, At, B1); PG8_BAR;
            PG8_LDA(At, 0, 1); PG8_STAGE(PG8_SA(0, 0), a2, voffA);
            PG8_BAR; PG8_WAIT_L(0); PG8_MMA(1, 0, At, B0); PG8_BAR; PG8_SCHED;
            PG8_STAGE(PG8_SB(0, 1), b2 + hstep, voffB);
            PG8_WAIT_V(6); PG8_BAR; PG8_MMA(1, 1, At, B1); PG8_BAR;
            PG8_LDB(B0, 1, 0); PG8_SCHED; PG8_LDA(At, 1, 0); PG8_STAGE(PG8_SA(0, 1), a2 + hstep, voffA);
            PG8_WAIT_L(8); PG8_BAR; PG8_WAIT_L(0); PG8_MMA(0, 0, At, B0); PG8_BAR; PG8_SCHED;
            PG8_LDB(B1, 1, 1); PG8_STAGE(PG8_SB(1, 0), b3, voffB);
            PG8_BAR; PG8_WAIT_L(0); PG8_MMA(0, 1, At, B1); PG8_BAR;
            PG8_LDA(At, 1, 1); PG8_STAGE(PG8_SA(1, 0), a3, voffA);
            PG8_BAR; PG8_WAIT_L(0); PG8_MMA(1, 0, At, B0); PG8_BAR; PG8_SCHED;
            PG8_STAGE(PG8_SB(1, 1), b3 + hstep, voffB);
            PG8_WAIT_V(6); PG8_BAR; PG8_MMA(1, 1, At, B1); PG8_BAR;
            }
        }
        if constexpr (ALIGN_EPI) { if (wr == 0) PG8_BAR; }
        if constexpr (!Epi::AFTER_DRAIN) { E(acc, cur, wr, wc, fr, fq); S.done(cur); }
        if (!has_next) break;
#pragma unroll
        for (int a = 0; a < 2; ++a)
#pragma unroll
            for (int b = 0; b < 2; ++b)
#pragma unroll
                for (int m = 0; m < 4; ++m)
#pragma unroll
                    for (int n = 0; n < 2; ++n) acc[a][b][m][n] = (f32x4){0.f, 0.f, 0.f, 0.f};
        cur = nxt; cA = nA; cB = nB; ++ui;
        if constexpr (ALIGN_EPI) { if (wr == 1) PG8_BAR; }
    }
    PG8_WAIT_V(0);
    if constexpr (!ALIGN_EPI) { if (wr == 0) PG8_BAR; }
    PG8_BAR;
    if constexpr (Epi::AFTER_DRAIN) { E.fused(acc, cur, wr, wc, fr, fq, lds, wid, lane); S.done(cur); }
#undef PG8_SA
#undef PG8_SB
#undef PG8_STAGE
#undef PG8_LDA
#undef PG8_LDB
#undef PG8_MMA
#undef PG8_WAIT_V
#undef PG8_WAIT_L
#undef PG8_BAR
#undef PG8_SCHED
}
}
namespace pg8 {
__device__ __forceinline__ float silu_fast(float v) { return v * __builtin_amdgcn_rcpf(1.0f + __expf(-v)); }
struct EpiRes {
    static constexpr bool PERM = false, AFTER_DRAIN = false;
    const float* base; float* out; const float* gate_all;
    __device__ __forceinline__ void operator()(const f32x4 (&acc)[2][2][4][2], const Unit& u, int wr, int wc, int fr, int fq) const {
        const float* gate = gate_all + (u.pm >> 4) * 6144;
        const int col0 = u.pn * BM + wc * 32 + 4 * fq;
        f32x4 gv[2][2];
#pragma unroll
        for (int bj = 0; bj < 2; ++bj)
#pragma unroll
            for (int n = 0; n < 2; ++n) gv[bj][n] = *(const f32x4*)(gate + col0 + bj * HALF + n * 16);
#pragma unroll
        for (int ai = 0; ai < 2; ++ai)
#pragma unroll
            for (int m = 0; m < 4; ++m) { const size_t off = (size_t)(u.pm * BM + ai * HALF + wr * 64 + m * 16 + fr) * 1024 + col0;
#pragma unroll
                for (int bj = 0; bj < 2; ++bj)
#pragma unroll
                    for (int n = 0; n < 2; ++n) { const f32x4 bs = *(const f32x4*)(base + off + bj * HALF + n * 16); *(f32x4*)(out + off + bj * HALF + n * 16) = bs + gv[bj][n] * acc[ai][bj][m][n]; } }
    }
};
struct EpiSwiglu {
    static constexpr bool PERM = true, AFTER_DRAIN = false;
    bf16_t* O;
    __device__ __forceinline__ void operator()(const f32x4 (&acc)[2][2][4][2], const Unit& u, int wr, int wc, int fr, int fq) const {
        const int row0 = u.pm * BM + wr * 64 + fr, col0 = u.pn * HALF + wc * 32 + 8 * fq;
#pragma unroll
        for (int ai = 0; ai < 2; ++ai)
#pragma unroll
            for (int m = 0; m < 4; ++m) { bf16_t* rowp = O + (size_t)(row0 + ai * HALF + m * 16) * 2816 + col0;
                const f32x4 g0 = acc[ai][0][m][0], g1 = acc[ai][0][m][1], u0 = acc[ai][1][m][0], u1 = acc[ai][1][m][1];
                u32x4 w; w.x = cvt_pk_bf16(silu_fast(g0[0]) * u0[0], silu_fast(g0[1]) * u0[1]); w.y = cvt_pk_bf16(silu_fast(g0[2]) * u0[2], silu_fast(g0[3]) * u0[3]);
                w.z = cvt_pk_bf16(silu_fast(g1[0]) * u1[0], silu_fast(g1[1]) * u1[1]); w.w = cvt_pk_bf16(silu_fast(g1[2]) * u1[2], silu_fast(g1[3]) * u1[3]);
                *(u32x4*)rowp = w; }
    }
};
struct EpiWin {
    static constexpr bool PERM = true, AFTER_DRAIN = false;
    bf16_t *QR, *KR, *VR, *GR;
    __device__ __forceinline__ void operator()(const f32x4 (&acc)[2][2][4][2], const Unit& u, int wr, int wc, int fr, int fq) const {
        const int pn = u.pn; bf16_t* base; int pitch, colt; bool act = false;
        if (pn < 4) { base = QR; pitch = 1024; colt = pn * BM; } else if (pn < 8) { base = KR; pitch = 1024; colt = (pn - 4) * BM; }
        else if (pn < 16) { base = VR; pitch = 2048; colt = (pn - 8) * BM; } else { base = GR; pitch = 2048; colt = (pn - 16) * BM; act = true; }
        const int row0 = u.pm * BM + wr * 64 + fr, col0 = colt + wc * 32 + 8 * fq;
#pragma unroll
        for (int ai = 0; ai < 2; ++ai)
#pragma unroll
            for (int m = 0; m < 4; ++m) { bf16_t* rowp = base + (size_t)(row0 + ai * HALF + m * 16) * pitch + col0;
#pragma unroll
                for (int bj = 0; bj < 2; ++bj) { f32x4 v0 = acc[ai][bj][m][0], v1 = acc[ai][bj][m][1];
                    if (act) { v0 = (f32x4){silu_fast(v0[0]), silu_fast(v0[1]), silu_fast(v0[2]), silu_fast(v0[3])}; v1 = (f32x4){silu_fast(v1[0]), silu_fast(v1[1]), silu_fast(v1[2]), silu_fast(v1[3])}; }
                    u32x4 w; w.x = cvt_pk_bf16(v0[0], v0[1]); w.y = cvt_pk_bf16(v0[2], v0[3]); w.z = cvt_pk_bf16(v1[0], v1[1]); w.w = cvt_pk_bf16(v1[2], v1[3]);
                    *(u32x4*)(rowp + bj * HALF) = w; } }
    }
};
}
#define GAS __attribute__((address_space(1)))
#define LAS __attribute__((address_space(3)))
typedef unsigned short bf16;
typedef unsigned v4u __attribute__((ext_vector_type(4)));
typedef float f32x4 __attribute__((ext_vector_type(4)));
typedef short bf16x8 __attribute__((ext_vector_type(8)));
typedef GAS unsigned gu32;
typedef GAS unsigned long long gu64;
#define RLX_AGENT __ATOMIC_RELAXED, __HIP_MEMORY_SCOPE_AGENT
#define LDS_WAIT() asm volatile("s_waitcnt lgkmcnt(0)" ::: "memory")
#define VM_WAIT() asm volatile("s_waitcnt vmcnt(0)" ::: "memory")
__device__ __forceinline__ unsigned long long rt() { return __builtin_amdgcn_s_memrealtime(); }
__device__ __forceinline__ unsigned f2bf(float f) { unsigned u = __builtin_bit_cast(unsigned, f); return (u + 0x7fffu + ((u >> 16) & 1u)) >> 16; }
__device__ __forceinline__ unsigned pk2(float lo, float hi) { return f2bf(lo) | (f2bf(hi) << 16); }

#define XB_TMO      128
#define XB_XCNT(j)  (256  + 64 * (j))
#define XB_XSUB(j)  (1280 + 64 * (j))
#define XB_XGEN(j)  (2304 + 64 * (j))
#define XB_TOP      3328
#define XB_TOPGEN   3392
#define XCD_BAR_WORDS 3456
#define XB_SPIN_CAP (1u << 18)

__device__ __forceinline__ unsigned xb_ld(unsigned* p)              { return __hip_atomic_load(p, __ATOMIC_RELAXED, __HIP_MEMORY_SCOPE_AGENT); }
__device__ __forceinline__ unsigned xb_add(unsigned* p, unsigned v) { return __hip_atomic_fetch_add(p, v, __ATOMIC_RELAXED, __HIP_MEMORY_SCOPE_AGENT); }
__device__ __forceinline__ unsigned xb_xcc_id() { return (unsigned)__builtin_amdgcn_s_getreg((3 << 11) | 20) & 0xFu; }
#define XB_SPIN(cond, bar) do { unsigned _sp = 0; while (cond) { __builtin_amdgcn_s_sleep(1); \
    if ((++_sp & 255u) == 0u) { if (xb_ld(&(bar)[XB_TMO])) break; if (_sp > XB_SPIN_CAP) { atomicAdd(&(bar)[XB_TMO], 1u); break; } } } } while (0)

struct XcdBarrier {
    unsigned* bar; unsigned x;
    volatile LAS unsigned* st;
};

__device__ __forceinline__ XcdBarrier xcd_barrier_post(unsigned* bar, volatile LAS unsigned* st) {
    XcdBarrier b; b.bar = bar; b.x = xb_xcc_id(); b.st = st;
    if (threadIdx.x == 0) (void)xb_add(&bar[XB_XCNT(b.x)], 1u);
    return b;
}
__device__ __forceinline__ void xcd_barrier_complete(unsigned* bar, unsigned x, unsigned& nloc, unsigned& nx) {
    const unsigned G = gridDim.x * gridDim.y * gridDim.z;
    unsigned sum, cnt, mine, sp = 0u;
    for (;;) {
        sum = 0u; cnt = 0u; mine = 0u;
#pragma unroll
        for (unsigned j = 0; j < 16; ++j) { const unsigned c = xb_ld(&bar[XB_XCNT(j)]); sum += c; cnt += (c > 0u) ? 1u : 0u; mine = (j == x) ? c : mine; }
        if (sum == G) break;
        __builtin_amdgcn_s_sleep(1);
        if ((++sp & 255u) == 0u) { if (xb_ld(&bar[XB_TMO])) break; if (sp > XB_SPIN_CAP) { atomicAdd(&bar[XB_TMO], 1u); break; } }
    }
    nloc = mine > 0u ? mine : 1u; nx = cnt > 0u ? cnt : 1u;
}

__device__ __forceinline__ void xcd_barrier(const XcdBarrier& b) {
    asm volatile("s_waitcnt vmcnt(0)" ::: "memory");
    __syncthreads();
    if (threadIdx.x == 0) {
        unsigned* bar = b.bar;
        __builtin_amdgcn_s_waitcnt(0);
        unsigned nloc = b.st[0], nx = b.st[1];
        if (nloc == 0u) { xcd_barrier_complete(bar, b.x, nloc, nx); b.st[0] = nloc; b.st[1] = nx; }
        const unsigned old = xb_add(&bar[XB_XSUB(b.x)], 1u);
        const unsigned gen = old / nloc;
        if (old + 1u == (gen + 1u) * nloc) {
            __builtin_amdgcn_fence(__ATOMIC_RELEASE, "agent");
            asm volatile("s_waitcnt vmcnt(0)" ::: "memory");
            const unsigned og = xb_add(&bar[XB_TOP], 1u);
            const unsigned tg = og / nx;
            if (og + 1u == (tg + 1u) * nx) xb_add(&bar[XB_TOPGEN], 1u);
            else XB_SPIN(xb_ld(&bar[XB_TOPGEN]) == tg, bar);
            __builtin_amdgcn_fence(__ATOMIC_ACQUIRE, "agent");
            xb_add(&bar[XB_XGEN(b.x)], 1u);
            asm volatile("s_waitcnt vmcnt(0)" ::: "memory");
        } else {
            XB_SPIN(xb_ld(&bar[XB_XGEN(b.x)]) == gen, bar);
            __builtin_amdgcn_fence(__ATOMIC_ACQUIRE, "agent");
            asm volatile("s_waitcnt vmcnt(0)" ::: "memory");
        }
    }
    __syncthreads();
}
constexpr int NWAVES = 8;
constexpr int NB = 4, SEQ = 4096, DM = 1024, MT = NB * SEQ;
constexpr int NQKV = 3072, DFF = 2816, NGU = 5632, NRIN = 6144, RV = 2048;
constexpr size_t MiB = 1u << 20;
constexpr size_t WS_CTL = 0, CTL_ZERO_BYTES = 1 * MiB;
constexpr size_t WS_ADA = 1 * MiB;
constexpr size_t WS_KMEAN = 1 * MiB + 256 * 1024;
constexpr size_t WS_CSA = 2 * MiB;
constexpr size_t WS_CSR = 3 * MiB;
constexpr size_t WS_H = 9 * MiB;
constexpr size_t WS_WIN = 41 * MiB;
constexpr size_t WS_WQKV = 53 * MiB, WS_WO = 59 * MiB, WS_GU0 = 61 * MiB, WS_D0 = 72 * MiB;
constexpr size_t WS_Q = 78 * MiB, WS_K = 110 * MiB, WS_V = 142 * MiB;
constexpr size_t WS_HMID0 = 78 * MiB;
constexpr size_t WS_QR = 53 * MiB, WS_KR = 85 * MiB, WS_VR = 117 * MiB, WS_GR = 181 * MiB;
constexpr size_t WS_GU1 = 245 * MiB;
constexpr size_t WS_WRO = 41 * MiB, WS_D1 = 45 * MiB;
constexpr size_t WS_HMID1 = 53 * MiB;
constexpr size_t WS_END = 256 * MiB;
constexpr int CW_TMO = 0, CW_CODE = 1, CW_BAR = 4096;
constexpr int RING_OFF = 0, RING_BYTES = 131072, LDSCTL_OFF = RING_BYTES, MISC_OFF = LDSCTL_OFF + 320, LDS_BYTES = 147456;

typedef unsigned v2u __attribute__((ext_vector_type(2)));
typedef float f32x2 __attribute__((ext_vector_type(2)));
__device__ __forceinline__ float bflo(unsigned w) { return __builtin_bit_cast(float, w << 16); }
__device__ __forceinline__ float bfhi(unsigned w) { return __builtin_bit_cast(float, w & 0xffff0000u); }
__device__ __forceinline__ float bf1(bf16 h) { return __builtin_bit_cast(float, (unsigned)h << 16); }
__device__ __forceinline__ void unpack8(v4u w, float (&f)[8]) { f[0] = bflo(w.x); f[1] = bfhi(w.x); f[2] = bflo(w.y); f[3] = bfhi(w.y); f[4] = bflo(w.z); f[5] = bfhi(w.z); f[6] = bflo(w.w); f[7] = bfhi(w.w); }
struct Frame {
    LAS unsigned char* lds; volatile LAS unsigned* MISC; gu32* ctl;
    int tid, lane, wave, vcu, G;
    const float *x, *c, *ada_w, *ada_b, *ng, *wqkv, *wo, *win, *gn, *rwo, *wgu, *wdn, *fng;
    float* out; unsigned char* ws;
};
__device__ __forceinline__ float wave_sum(float v) {
#pragma unroll
    for (int o = 1; o < 64; o <<= 1) v += __shfl_xor(v, o);
    return v;
}
__device__ __forceinline__ float silu_f(float v) { return v / (1.f + __expf(-v)); }

__device__ __forceinline__ void transpose_item(const float* W, int K, int N, bf16* WT, int k0, int n0, int drow0, LAS float* scr, int lane) {
#pragma unroll 8
    for (int i = 0; i < 32; ++i) { const int kk = 2 * i + (lane >> 5); scr[kk * 33 + (lane & 31)] = W[(size_t)(k0 + kk) * N + n0 + (lane & 31)]; }
    LDS_WAIT(); asm volatile("" ::: "memory");
    const int c = lane & 7;
#pragma unroll
    for (int j = 0; j < 4; ++j) { const int n = (lane >> 3) + 8 * j; const LAS float* s = scr + (8 * c) * 33 + n;
        v4u o; o.x = pk2(s[0 * 33], s[1 * 33]); o.y = pk2(s[2 * 33], s[3 * 33]); o.z = pk2(s[4 * 33], s[5 * 33]); o.w = pk2(s[6 * 33], s[7 * 33]);
        *(GAS v4u*)(WT + (size_t)(drow0 + n) * K + k0 + 8 * c) = o; }
    LDS_WAIT(); asm volatile("" ::: "memory");
}
__device__ __forceinline__ void convert_matrix(Frame& F, const float* W, int K, int N, bf16* WT, bool GU, int& itbase) {
    LAS float* scr = (LAS float*)(F.lds + RING_OFF + F.wave * 16384);
    const int gw = F.vcu * NWAVES + F.wave, NGW = F.G * NWAVES;
    const int nblk = N / 32, nitems = (K / 64) * nblk;
    int first = (gw - itbase % NGW + NGW) % NGW;
    for (int it = first; it < nitems; it += NGW) {
        const int kb = it / nblk, nb = it % nblk, n0 = 32 * nb;
        int drow0 = n0;
        if (GU) drow0 = (n0 < DFF) ? (n0 / 128) * 256 + (n0 % 128) : ((n0 - DFF) / 128) * 256 + 128 + ((n0 - DFF) % 128);
        transpose_item(W, K, N, WT, 64 * kb, n0, drow0, scr, F.lane);
    }
    itbase += nitems;
}

__device__ __forceinline__ void p0_prologue(Frame& F) {
    {
        LAS float* sc = (LAS float*)(F.lds + RING_OFF);
        LAS float* red = (LAS float*)(F.lds + RING_OFF + 16384);
        for (int u = blockIdx.x; u < 192; u += F.G) {
            for (int i = F.tid; i < 4096; i += 512) sc[i] = silu_f(F.c[i]);
            __syncthreads();
            const int l = u / 96, n = (u % 96) * 64 + F.lane;
            const float* wp = F.ada_w + (size_t)l * 1024 * 6144 + n;
            float a0 = 0.f, a1 = 0.f, a2 = 0.f, a3 = 0.f;
            const int kb = F.wave * 128;
#pragma unroll 8
            for (int k = kb; k < kb + 128; ++k) { const float wv = wp[(size_t)k * 6144]; a0 += sc[k] * wv; a1 += sc[1024 + k] * wv; a2 += sc[2048 + k] * wv; a3 += sc[3072 + k] * wv; }
            red[(F.wave * 4 + 0) * 64 + F.lane] = a0; red[(F.wave * 4 + 1) * 64 + F.lane] = a1; red[(F.wave * 4 + 2) * 64 + F.lane] = a2; red[(F.wave * 4 + 3) * 64 + F.lane] = a3;
            __syncthreads();
            if (F.wave < 4) { float s = 0.f;
#pragma unroll
                for (int w = 0; w < 8; ++w) s += red[(w * 4 + F.wave) * 64 + F.lane];
                float* m = (float*)(F.ws + WS_ADA);
                m[(size_t)(l * 4 + F.wave) * 6144 + n] = s + F.ada_b[l * 6144 + n]; }
            __syncthreads();
        }
    }
    {
        f32x2* csa = (f32x2*)(F.ws + WS_CSA); f32x2* csr = (f32x2*)(F.ws + WS_CSR);
        const int gt = F.vcu * 512 + F.tid, NT = F.G * 512;
        for (int i = gt; i < SEQ * 32; i += NT) { const int pos = i >> 5, j = i & 31; const double rev = (double)pos * INV64[j] * 0.15915494309189535; const float a = (float)((rev - rint(rev)) * 6.283185307179586); csa[i] = (f32x2){__cosf(a), __sinf(a)}; }
        for (int i = gt; i < SEQ * 128; i += NT) { const int pos = i >> 7, j = i & 127; const double rev = (double)pos * INV256[j] * 0.15915494309189535; const float a = (float)((rev - rint(rev)) * 6.283185307179586); csr[i] = (f32x2){__cosf(a), __sinf(a)}; }
    }
    __syncthreads();
    int itbase = 0;
    convert_matrix(F, F.wqkv, DM, NQKV, (bf16*)(F.ws + WS_WQKV), false, itbase);
    convert_matrix(F, F.wo, DM, DM, (bf16*)(F.ws + WS_WO), false, itbase);
    convert_matrix(F, F.wgu, DM, NGU, (bf16*)(F.ws + WS_GU0), true, itbase);
    convert_matrix(F, F.wdn, DFF, DM, (bf16*)(F.ws + WS_D0), false, itbase);
    convert_matrix(F, F.win, DM, NRIN, (bf16*)(F.ws + WS_WIN), false, itbase);
}
__device__ __forceinline__ void convert_set_b(Frame& F) {
    int itbase = 0;
    convert_matrix(F, F.rwo, RV, DM, (bf16*)(F.ws + WS_WRO), false, itbase);
    convert_matrix(F, F.wgu + (size_t)DM * NGU, DM, NGU, (bf16*)(F.ws + WS_GU1), true, itbase);
    convert_matrix(F, F.wdn + (size_t)DFF * DM, DFF, DM, (bf16*)(F.ws + WS_D1), false, itbase);
}

__device__ __forceinline__ void norm_mod_phase(Frame& F, const float* xsrc, const float* gain, int layer, int shift_chunk) {
    const int gw = F.vcu * NWAVES + F.wave, NGW = F.G * NWAVES;
    bf16* H = (bf16*)(F.ws + WS_H);
    const float* ada = (const float*)(F.ws + WS_ADA);
    for (int m = gw; m < MT; m += NGW) {
        const int b = m >> 12;
        const float* am = ada + (size_t)(layer * 4 + b) * 6144 + shift_chunk * 1024;
        const GAS f32x4* xr = (const GAS f32x4*)(xsrc + (size_t)m * DM) + F.lane;
        f32x4 v[4]; float s = 0.f;
#pragma unroll
        for (int j = 0; j < 4; ++j) { v[j] = xr[64 * j]; s += (v[j].x * v[j].x + v[j].y * v[j].y) + (v[j].z * v[j].z + v[j].w * v[j].w); }
        const float rstd = 1.0f / sqrtf(wave_sum(s) * (1.f / DM) + 1e-6f);
        GAS v2u* o8 = (GAS v2u*)(H + (size_t)m * DM) + F.lane;
#pragma unroll
        for (int j = 0; j < 4; ++j) {
            const f32x4 g = *((const f32x4*)gain + F.lane + 64 * j), sh = *((const f32x4*)am + F.lane + 64 * j), sc = *((const f32x4*)(am + 1024) + F.lane + 64 * j);
            const f32x4 r = v[j] * rstd * g * (sc + 1.0f) + sh;
            o8[64 * j] = (v2u){pk2(r.x, r.y), pk2(r.z, r.w)};
        }
    }
}
__device__ __forceinline__ void final_norm_phase(Frame& F) {
    const int gw = F.vcu * NWAVES + F.wave, NGW = F.G * NWAVES;
    for (int m = gw; m < MT; m += NGW) {
        GAS f32x4* xr = (GAS f32x4*)(F.out + (size_t)m * DM) + F.lane;
        f32x4 v[4]; float s = 0.f;
#pragma unroll
        for (int j = 0; j < 4; ++j) { v[j] = xr[64 * j]; s += (v[j].x * v[j].x + v[j].y * v[j].y) + (v[j].z * v[j].z + v[j].w * v[j].w); }
        const float rstd = 1.0f / sqrtf(wave_sum(s) * (1.f / DM) + 1e-6f);
#pragma unroll
        for (int j = 0; j < 4; ++j) { const f32x4 g = *((const f32x4*)F.fng + F.lane + 64 * j); xr[64 * j] = v[j] * rstd * g; }
    }
}
__device__ __forceinline__ void rope_att_phase(Frame& F) {
    const int gt = F.vcu * 512 + F.tid, NT = F.G * 512;
    const f32x2* csa = (const f32x2*)(F.ws + WS_CSA);
    for (int i = gt; i < MT * 2 * 8 * 4; i += NT) {
        const int i8 = i & 3, hd = (i >> 2) & 7, which = (i >> 5) & 1, row = i >> 6, pos = row & (SEQ - 1);
        bf16* p = (bf16*)(F.ws + (which ? WS_K : WS_Q)) + (size_t)row * DM + (8 + hd) * 64 + i8 * 8;
        const v4u a = *(const v4u*)p, b = *(const v4u*)(p + 32);
        float x1[8], x2[8], o1[8], o2[8]; unpack8(a, x1); unpack8(b, x2);
#pragma unroll
        for (int j = 0; j < 8; ++j) { const f32x2 cs = csa[pos * 32 + i8 * 8 + j]; o1[j] = x1[j] * cs.x - x2[j] * cs.y; o2[j] = x2[j] * cs.x + x1[j] * cs.y; }
        *(v4u*)p = (v4u){pk2(o1[0], o1[1]), pk2(o1[2], o1[3]), pk2(o1[4], o1[5]), pk2(o1[6], o1[7])};
        *(v4u*)(p + 32) = (v4u){pk2(o2[0], o2[1]), pk2(o2[2], o2[3]), pk2(o2[4], o2[5]), pk2(o2[6], o2[7])};
    }
}
__device__ __forceinline__ double ret_lg2g(int h) { return h == 0 ? -0.045803689613124789 : (h == 1 ? -0.022720076500083529 : (h == 2 ? -0.011315313227834146 : -0.0056465631411420627)); }
__device__ __forceinline__ void rope_ret_phase(Frame& F) {
    const int gt = F.vcu * 512 + F.tid, NT = F.G * 512;
    const f32x2* csr = (const f32x2*)(F.ws + WS_CSR);
    for (int i = gt; i < MT * 2 * 4 * 16; i += NT) {
        const int i8 = i & 15, hd = (i >> 4) & 3, which = (i >> 6) & 1, row = i >> 7, pos = row & (SEQ - 1);
        bf16* p = (bf16*)(F.ws + (which ? WS_KR : WS_QR)) + (size_t)row * DM + hd * 256 + i8 * 8;
        const v4u a = *(const v4u*)p, b = *(const v4u*)(p + 128);
        const float dec = exp2f((float)(pos & 63) * (float)ret_lg2g(hd));
        const float scl = which ? 0.0625f / dec : dec;
        float x1[8], x2[8], o1[8], o2[8]; unpack8(a, x1); unpack8(b, x2);
#pragma unroll
        for (int j = 0; j < 8; ++j) { const f32x2 cs = csr[pos * 128 + i8 * 8 + j]; o1[j] = (x1[j] * cs.x - x2[j] * cs.y) * scl; o2[j] = (x2[j] * cs.x + x1[j] * cs.y) * scl; }
        *(v4u*)p = (v4u){pk2(o1[0], o1[1]), pk2(o1[2], o1[3]), pk2(o1[4], o1[5]), pk2(o1[6], o1[7])};
        *(v4u*)(p + 128) = (v4u){pk2(o2[0], o2[1]), pk2(o2[2], o2[3]), pk2(o2[4], o2[5]), pk2(o2[6], o2[7])};
    }
}
__device__ __forceinline__ void kmean_phase(Frame& F) {
    const int gw = F.vcu * NWAVES + F.wave, NGW = F.G * NWAVES;
    const bf16* K = (const bf16*)(F.ws + WS_K); float* km = (float*)(F.ws + WS_KMEAN);
    for (int u = gw; u < NB * 8 * 16; u += NGW) {
        const int n = u & 15, hd = (u >> 4) & 7, b = u >> 7;
        const bf16* kp = K + (size_t)(b * SEQ + n * 256) * DM + (8 + hd) * 64 + F.lane;
        float s = 0.f;
#pragma unroll 8
        for (int j = 0; j < 256; ++j) s += bf1(kp[(size_t)j * DM]);
        km[u * 64 + F.lane] = s * (1.0f / 256.0f);
    }
}
__device__ __forceinline__ void sb_unit(Frame& F, int b, int h, int blk) {
    const bf16* Q = (const bf16*)(F.ws + WS_Q); const bf16* K = (const bf16*)(F.ws + WS_K); const bf16* V = (const bf16*)(F.ws + WS_V);
    const int t = blk * 64 + F.lane, tmax = blk * 64 + 63;
    const size_t rb = (size_t)b * SEQ;
    v4u qv[8]; float o[64];
    { const v4u* qp = (const v4u*)(Q + (rb + t) * DM + h * 64);
#pragma unroll
      for (int c = 0; c < 8; ++c) { qv[c] = qp[c];
#pragma unroll
          for (int j = 0; j < 8; ++j) o[c * 8 + j] = 0.f; } }
    float R = 0.f; bool done = false;
#pragma unroll 1
    for (int s = tmax - 1; s >= 0; --s) {
        const v4u* kp = (const v4u*)(K + (rb + s) * DM + h * 64);
        float z = 0.f;
#pragma unroll
        for (int c = 0; c < 8; ++c) { float f[8], qf[8]; unpack8(kp[c], f); unpack8(qv[c], qf);
#pragma unroll
            for (int j = 0; j < 8; ++j) z += qf[j] * f[j]; }
        z *= 0.125f;
        if (s < t && !done) {
            const float L = -(fmaxf(z, 0.f) + log1pf(__expf(-fabsf(z))));
            const float a = __expf(z + L + R);
            const v4u* vp = (const v4u*)(V + (rb + s) * DM + h * 64);
#pragma unroll
            for (int c = 0; c < 8; ++c) { float f[8]; unpack8(vp[c], f);
#pragma unroll
                for (int j = 0; j < 8; ++j) o[c * 8 + j] += a * f[j]; }
            R += L;
            if (R < -100.f) done = true;
        }
        if (__all(done || t == 0)) break;
    }
    v4u* op = (v4u*)((bf16*)(F.ws + WS_Q) + (rb + t) * DM + h * 64);
#pragma unroll
    for (int c = 0; c < 8; ++c) op[c] = (v4u){pk2(o[c * 8], o[c * 8 + 1]), pk2(o[c * 8 + 2], o[c * 8 + 3]), pk2(o[c * 8 + 4], o[c * 8 + 5]), pk2(o[c * 8 + 6], o[c * 8 + 7])};
}
__device__ __forceinline__ void moba_unit(Frame& F, int b, int hd, int blk) {
    const int head = 8 + hd;
    const bf16* Q = (const bf16*)(F.ws + WS_Q); const bf16* K = (const bf16*)(F.ws + WS_K); const bf16* V = (const bf16*)(F.ws + WS_V);
    const float* kmean = (const float*)(F.ws + WS_KMEAN) + (size_t)(b * 8 + hd) * 16 * 64;
    const int t = blk * 64 + F.lane, tmax = blk * 64 + 63, own = blk >> 2;
    const size_t rb = (size_t)b * SEQ;
    v4u qv[8]; float o[64];
    { const v4u* qp = (const v4u*)(Q + (rb + t) * DM + head * 64);
#pragma unroll
      for (int c = 0; c < 8; ++c) { qv[c] = qp[c];
#pragma unroll
          for (int j = 0; j < 8; ++j) o[c * 8 + j] = 0.f; } }
    unsigned sel = 0u;
    if (own <= 3) sel = (1u << own) - 1u;
    else {
        float b1 = -3e38f, b2 = -3e38f, b3 = -3e38f; int i1 = 0, i2 = 0, i3 = 0;
#pragma unroll 1
        for (int n = 0; n < own; ++n) {
            const float* km = kmean + n * 64; float a = 0.f;
#pragma unroll
            for (int c = 0; c < 8; ++c) { float qf[8]; unpack8(qv[c], qf);
#pragma unroll
                for (int j = 0; j < 8; ++j) a += qf[j] * km[c * 8 + j]; }
            if (a > b1) { b3 = b2; i3 = i2; b2 = b1; i2 = i1; b1 = a; i1 = n; }
            else if (a > b2) { b3 = b2; i3 = i2; b2 = a; i2 = n; }
            else if (a > b3) { b3 = a; i3 = n; }
        }
        sel = (1u << i1) | (1u << i2) | (1u << i3);
    }
    float m = -1e30f, l = 0.f;
    for (int n = 0; n <= own; ++n) {
        const bool mine = (n == own) || ((sel >> n) & 1u);
        if (!__any(mine)) continue;
        const int s1 = (n == own) ? tmax : n * 256 + 255;
#pragma unroll 1
        for (int s = n * 256; s <= s1; ++s) {
            const v4u* kp = (const v4u*)(K + (rb + s) * DM + head * 64);
            float sc = 0.f;
#pragma unroll
            for (int c = 0; c < 8; ++c) { float f[8], qf[8]; unpack8(kp[c], f); unpack8(qv[c], qf);
#pragma unroll
                for (int j = 0; j < 8; ++j) sc += qf[j] * f[j]; }
            sc *= 0.125f;
            if (mine && s <= t) {
                if (sc > m) { const float f = __expf(m - sc); l *= f;
#pragma unroll
                    for (int d = 0; d < 64; ++d) o[d] *= f;
                    m = sc; }
                const float p = __expf(sc - m); l += p;
                const v4u* vp = (const v4u*)(V + (rb + s) * DM + head * 64);
#pragma unroll
                for (int c = 0; c < 8; ++c) { float f[8]; unpack8(vp[c], f);
#pragma unroll
                    for (int j = 0; j < 8; ++j) o[c * 8 + j] += p * f[j]; }
            }
        }
    }
    const float il = 1.0f / l;
    v4u* op = (v4u*)((bf16*)(F.ws + WS_Q) + (rb + t) * DM + head * 64);
#pragma unroll
    for (int c = 0; c < 8; ++c) op[c] = (v4u){pk2(o[c * 8] * il, o[c * 8 + 1] * il), pk2(o[c * 8 + 2] * il, o[c * 8 + 3] * il), pk2(o[c * 8 + 4] * il, o[c * 8 + 5] * il), pk2(o[c * 8 + 6] * il, o[c * 8 + 7] * il)};
}
__device__ __forceinline__ void attn_naive_phase(Frame& F) {
    const int gw = F.vcu * NWAVES + F.wave, NGW = F.G * NWAVES;
    for (int u = gw; u < NB * 64 * 16; u += NGW) {
        const int head = u & 15, blk = (u >> 4) & 63, b = u >> 10;

#ifndef NOSB
        if (head < 8) sb_unit(F, b, head, blk);
#endif
#ifndef NOMOBA
        if (head >= 8) moba_unit(F, b, head - 8, blk);
#endif

    }
}
__device__ __forceinline__ void ret_naive_phase(Frame& F) {
    LAS float* red = (LAS float*)(F.lds + RING_OFF);
    const bf16* QR = (const bf16*)(F.ws + WS_QR); const bf16* KR = (const bf16*)(F.ws + WS_KR); bf16* VR = (bf16*)(F.ws + WS_VR);
    const int tid = F.tid, dvi = tid & 31, dkg = tid >> 5;
    for (int u = blockIdx.x; u < NB * 4 * 16; u += F.G) {
        const int sl = u & 15, h = (u >> 4) & 3, b = u >> 6;
        const float gamma = 1.0f - 1.0f / (float)(32 << h);
        float S[16];
#pragma unroll
        for (int i = 0; i < 16; ++i) S[i] = 0.f;
        const size_t rb = (size_t)b * SEQ;
        const bf16* qb = QR + rb * DM + h * 256 + dkg * 16; const bf16* kb = KR + rb * DM + h * 256 + dkg * 16;
        bf16* vb = VR + rb * RV + h * 512 + sl * 32 + dvi;
        v4u qn0 = *(const v4u*)qb, qn1 = *(const v4u*)(qb + 8), kn0 = *(const v4u*)kb, kn1 = *(const v4u*)(kb + 8); bf16 vn = vb[0];
        for (int t = 0; t < SEQ; ++t) {
            float qc[16], kc[16]; { float f[8]; unpack8(qn0, f);
#pragma unroll
                for (int j = 0; j < 8; ++j) qc[j] = f[j];
                unpack8(qn1, f);
#pragma unroll
                for (int j = 0; j < 8; ++j) qc[8 + j] = f[j];
                unpack8(kn0, f);
#pragma unroll
                for (int j = 0; j < 8; ++j) kc[j] = f[j];
                unpack8(kn1, f);
#pragma unroll
                for (int j = 0; j < 8; ++j) kc[8 + j] = f[j]; }
            const float v = bf1(vn);
            if (t + 1 < SEQ) { const size_t o1 = (size_t)(t + 1) * DM; qn0 = *(const v4u*)(qb + o1); qn1 = *(const v4u*)(qb + o1 + 8); kn0 = *(const v4u*)(kb + o1); kn1 = *(const v4u*)(kb + o1 + 8); vn = vb[(size_t)(t + 1) * RV]; }
            float po = 0.f;
#pragma unroll
            for (int i = 0; i < 16; ++i) { S[i] = gamma * S[i] + kc[i] * v; po += qc[i] * S[i]; }
            red[((t & 1) * 16 + dkg) * 32 + dvi] = po;
            __syncthreads();
            if (tid < 32) { float s = 0.f;
#pragma unroll
                for (int j = 0; j < 16; ++j) s += red[((t & 1) * 16 + j) * 32 + tid];
                vb[(size_t)t * RV] = (bf16)f2bf(s); }
        }
        __syncthreads();
    }
}
__device__ __forceinline__ void gn_gate_phase(Frame& F) {
    const int gw = F.vcu * NWAVES + F.wave, NGW = F.G * NWAVES;
    bf16* VR = (bf16*)(F.ws + WS_VR); const bf16* GR = (const bf16*)(F.ws + WS_GR);
    for (int u = gw; u < MT * 4; u += NGW) {
        const int h = u & 3, row = u >> 2;
        bf16* op = VR + (size_t)row * RV + h * 512 + F.lane * 8;
        float v[8], g[8]; unpack8(*(const v4u*)op, v); unpack8(*(const v4u*)(GR + (size_t)row * RV + h * 512 + F.lane * 8), g);
        float s = 0.f;
#pragma unroll
        for (int i = 0; i < 8; ++i) s += v[i];
        const float mu = wave_sum(s) * (1.0f / 512.0f); float q = 0.f;
#pragma unroll
        for (int i = 0; i < 8; ++i) { v[i] -= mu; q += v[i] * v[i]; }
        const float rs = 1.0f / sqrtf(wave_sum(q) * (1.0f / 512.0f) + 1e-5f);
        const float* gg = F.gn + h * 512 + F.lane * 8;
        float r[8];
#pragma unroll
        for (int i = 0; i < 8; ++i) r[i] = g[i] * (v[i] * rs * gg[i]);
        *(v4u*)op = (v4u){pk2(r[0], r[1]), pk2(r[2], r[3]), pk2(r[4], r[5]), pk2(r[6], r[7])};
    }
}
namespace ret {
typedef short bf16x8 __attribute__((ext_vector_type(8)));
typedef short s16x4 __attribute__((ext_vector_type(4)));
typedef float f32x16 __attribute__((ext_vector_type(16)));
constexpr int QP = 528, KP = 576, VP = 576, PP = 144;
constexpr int L_Q = 0, L_K = 64 * QP, L_V = L_K + 64 * KP, L_P = L_V + 64 * VP, L_END = L_P + 64 * PP;
static_assert(L_END <= RING_BYTES, "retention LDS");
__device__ __forceinline__ s16x4 trd(const LAS unsigned char* p) { return __builtin_bit_cast(s16x4, __builtin_amdgcn_ds_read_tr16_b64_v4i16((LAS s16x4*)p)); }
__device__ __forceinline__ bf16x8 cat8(s16x4 a, s16x4 b) { return (bf16x8){a[0], a[1], a[2], a[3], b[0], b[1], b[2], b[3]}; }
__device__ __forceinline__ bf16x8 ldf(const LAS unsigned char* p) { return *(const LAS bf16x8*)p; }
__device__ __forceinline__ void stage_perm(LAS unsigned char* dst, int pitch, const bf16* src, size_t gp, int tid) {
#pragma unroll
    for (int i = 0; i < 4; ++i) { const int id = tid + 512 * i, row = id >> 5, c8 = id & 31;
        const v4u v = *(const v4u*)(src + (size_t)row * gp + c8 * 8);
        LAS unsigned char* d = dst + row * pitch + 32 * (c8 >> 1) + 8 * (c8 & 1);
        *(LAS v2u*)d = (v2u){v.x, v.y}; *(LAS v2u*)(d + 16) = (v2u){v.z, v.w}; }
}
__device__ __forceinline__ void stage_nat(LAS unsigned char* dst, int pitch, const bf16* src, size_t gp, int tid) {
#pragma unroll
    for (int i = 0; i < 4; ++i) { const int id = tid + 512 * i, row = id >> 5, c8 = id & 31;
        *(LAS v4u*)(dst + row * pitch + 16 * c8) = *(const v4u*)(src + (size_t)row * gp + c8 * 8); }
}
__device__ __forceinline__ bf16x8 acc2frag(const f32x16& x, int s) {
    v4u w; w.x = pk2(x[8 * s + 0], x[8 * s + 1]); w.y = pk2(x[8 * s + 2], x[8 * s + 3]); w.z = pk2(x[8 * s + 4], x[8 * s + 5]); w.w = pk2(x[8 * s + 6], x[8 * s + 7]);
    return __builtin_bit_cast(bf16x8, w);
}

template <bool OUT> __device__ __forceinline__ void ret_unit(Frame& F, int b, int h, int seg, int slice) {
    const int tid = F.tid, lane = F.lane, w = F.wave, r = lane & 31, hi = lane >> 5;
    const int g1 = (lane >> 4) & 1, q4 = (lane & 15) >> 2, p4 = lane & 3, ppos = (p4 == 1) ? 2 : ((p4 == 2) ? 1 : p4);
    LAS unsigned char* Qs = F.lds + RING_OFF + L_Q; LAS unsigned char* Ks = F.lds + RING_OFF + L_K; LAS unsigned char* Vs = F.lds + RING_OFF + L_V; LAS unsigned char* Ps = F.lds + RING_OFF + L_P;
    const float lg = (float)ret_lg2g(h);
    const float g64 = exp2f(64.0f * lg);
    const size_t row0 = (size_t)b * SEQ + (size_t)seg * 512;
    const bf16* Qg = (const bf16*)(F.ws + WS_QR) + row0 * DM + h * 256;
    const bf16* Kg = (const bf16*)(F.ws + WS_KR) + row0 * DM + h * 256;
    bf16* Vg = (bf16*)(F.ws + WS_VR) + row0 * RV + h * 512 + slice * 256;
    v4u* snap = (v4u*)(F.ws + WS_H);
    f32x16 R[8];
#pragma unroll
    for (int d = 0; d < 8; ++d) R[d] = (f32x16){};
    if (OUT) {
        for (int j = 0; j < seg; ++j) {
            const float f = exp2f(512.0f * (float)(seg - 1 - j) * lg);
            const size_t u1 = ((size_t)((b * 4 + h) * 7 + j) * 2 + slice) * 8 + w;
#pragma unroll
            for (int d = 0; d < 8; ++d)
#pragma unroll
                for (int pc = 0; pc < 2; ++pc) { const v4u v = snap[((u1 * 8 + d) * 2 + pc) * 64 + lane]; float x[8]; unpack8(v, x);
#pragma unroll
                    for (int e = 0; e < 8; ++e) R[d][8 * pc + e] += f * x[e]; }
        }
    }
    const int frag_off = 16 * hi;
    const int trk_off = (8 * hi + q4) * KP + 32 * g1 + 8 * ppos;
    const int trv_off = (8 * hi + q4) * VP + 2 * (32 * w + 16 * g1 + 4 * p4);
    for (int c = 0; c < 8; ++c) {
        if (OUT) stage_perm(Qs, QP, Qg + (size_t)c * 64 * DM, DM, tid);
        stage_perm(Ks, KP, Kg + (size_t)c * 64 * DM, DM, tid);
        stage_nat(Vs, VP, Vg + (size_t)c * 64 * RV, RV, tid);
        __syncthreads();
        if (c > 0 || OUT) {
#pragma unroll
            for (int d = 0; d < 8; ++d) R[d] = R[d] * g64;
        }
        f32x16 O0 = (f32x16){}, O1 = (f32x16){};
        if (OUT) {
            if (w < 4) {
                const int tj = w >> 1, ti = w & 1;
                f32x16 pa = (f32x16){};
                if (!(tj == 1 && ti == 0)) {
#pragma unroll
                    for (int ks = 0; ks < 16; ++ks) { const bf16x8 a = ldf(Ks + (32 * tj + r) * KP + 32 * ks + frag_off), bq = ldf(Qs + (32 * ti + r) * QP + 32 * ks + frag_off);
                        pa = __builtin_amdgcn_mfma_f32_32x32x16_bf16(a, bq, pa, 0, 0, 0); }
                }
#pragma unroll
                for (int g = 0; g < 4; ++g) { float v[4];
#pragma unroll
                    for (int e = 0; e < 4; ++e) { const int jl = 8 * g + 4 * hi + e; v[e] = (tj == ti && jl > r) ? 0.f : pa[4 * g + e]; }
                    *(LAS v2u*)(Ps + (32 * ti + r) * PP + 2 * (32 * tj + 8 * g + 4 * hi)) = (v2u){pk2(v[0], v[1]), pk2(v[2], v[3])}; }
            }
#pragma unroll
            for (int d = 0; d < 8; ++d)
#pragma unroll
                for (int s = 0; s < 2; ++s) { const bf16x8 a = acc2frag(R[d], s);
                    const bf16x8 b0 = ldf(Qs + r * QP + 32 * (2 * d + s) + frag_off), b1 = ldf(Qs + (32 + r) * QP + 32 * (2 * d + s) + frag_off);
                    O0 = __builtin_amdgcn_mfma_f32_32x32x16_bf16(a, b0, O0, 0, 0, 0); O1 = __builtin_amdgcn_mfma_f32_32x32x16_bf16(a, b1, O1, 0, 0, 0); }
            __syncthreads();
        }
        bf16x8 vf[4];
#pragma unroll
        for (int s = 0; s < 4; ++s) vf[s] = cat8(trd(Vs + trv_off + (16 * s) * VP), trd(Vs + trv_off + (16 * s + 4) * VP));
        if (OUT) {
#pragma unroll
            for (int s = 0; s < 4; ++s) {
                if (s < 2) O0 = __builtin_amdgcn_mfma_f32_32x32x16_bf16(vf[s], ldf(Ps + r * PP + 32 * s + frag_off), O0, 0, 0, 0);
                O1 = __builtin_amdgcn_mfma_f32_32x32x16_bf16(vf[s], ldf(Ps + (32 + r) * PP + 32 * s + frag_off), O1, 0, 0, 0);
            }
        }
#pragma unroll
        for (int d = 0; d < 8; ++d)
#pragma unroll
            for (int s = 0; s < 4; ++s) { const bf16x8 a = cat8(trd(Ks + trk_off + (16 * s) * KP + 64 * d), trd(Ks + trk_off + (16 * s + 4) * KP + 64 * d));
                R[d] = __builtin_amdgcn_mfma_f32_32x32x16_bf16(a, vf[s], R[d], 0, 0, 0); }
        if (OUT) {
            bf16* o0 = Vg + (size_t)(c * 64 + r) * RV + 32 * w + 4 * hi; bf16* o1 = o0 + (size_t)32 * RV;
#pragma unroll
            for (int g = 0; g < 4; ++g) { *(v2u*)(o0 + 8 * g) = (v2u){pk2(O0[4 * g], O0[4 * g + 1]), pk2(O0[4 * g + 2], O0[4 * g + 3])};
                *(v2u*)(o1 + 8 * g) = (v2u){pk2(O1[4 * g], O1[4 * g + 1]), pk2(O1[4 * g + 2], O1[4 * g + 3])}; }
        }
        __syncthreads();
    }
    if (!OUT) {
        const size_t u1 = ((size_t)((b * 4 + h) * 7 + seg) * 2 + slice) * 8 + w;
#pragma unroll
        for (int d = 0; d < 8; ++d)
#pragma unroll
            for (int pc = 0; pc < 2; ++pc) snap[((u1 * 8 + d) * 2 + pc) * 64 + lane] = __builtin_bit_cast(v4u, acc2frag(R[d], pc));
    }
}
__device__ __forceinline__ void pass1_phase(Frame& F) {
    for (int u = blockIdx.x; u < NB * 4 * 7 * 2; u += F.G) { const int slice = u & 1, seg = (u >> 1) % 7, bh = (u >> 1) / 7; ret_unit<false>(F, bh >> 2, bh & 3, seg, slice); }
}
__device__ __forceinline__ void pass2_phase(Frame& F) {
    for (int u = blockIdx.x; u < NB * 4 * 8 * 2; u += F.G) { const int slice = u & 1, seg = (u >> 1) & 7, bh = u >> 4; ret_unit<true>(F, bh >> 2, bh & 3, seg, slice); }
}
}
namespace att {
typedef short bf16x8 __attribute__((ext_vector_type(8)));
typedef short s16x4 __attribute__((ext_vector_type(4)));
typedef float f32x16 __attribute__((ext_vector_type(16)));
constexpr int KPITCH = 144, VPITCH = 192;
__device__ __forceinline__ s16x4 trd(const LAS unsigned char* p) { return __builtin_bit_cast(s16x4, __builtin_amdgcn_ds_read_tr16_b64_v4i16((LAS s16x4*)p)); }
__device__ __forceinline__ bf16x8 cat8(s16x4 a, s16x4 b) { return (bf16x8){a[0], a[1], a[2], a[3], b[0], b[1], b[2], b[3]}; }
__device__ __forceinline__ bf16x8 ldf(const LAS unsigned char* p) { return *(const LAS bf16x8*)p; }
__device__ __forceinline__ bf16x8 pfrag(const f32x16& x, int s) {
    v4u w; w.x = pk2(x[8 * s + 0], x[8 * s + 1]); w.y = pk2(x[8 * s + 2], x[8 * s + 3]); w.z = pk2(x[8 * s + 4], x[8 * s + 5]); w.w = pk2(x[8 * s + 6], x[8 * s + 7]);
    return __builtin_bit_cast(bf16x8, w);
}
__device__ __forceinline__ void sb_wave_unit(Frame& F, int b, int h, int qblk) {
    const int lane = F.lane, r = lane & 31, hi = lane >> 5, g1 = (lane >> 4) & 1, q4 = (lane & 15) >> 2, p4 = lane & 3;
    LAS unsigned char* Kt = F.lds + RING_OFF + F.wave * 12288; LAS unsigned char* Vt = Kt + 4608;
    const size_t rb = (size_t)b * SEQ; const int q0 = qblk * 32;
    bf16* Qp = (bf16*)(F.ws + WS_Q) + (rb + q0 + r) * DM + h * 64;
    const bf16* Kg = (const bf16*)(F.ws + WS_K) + rb * DM + h * 64; const bf16* Vg = (const bf16*)(F.ws + WS_V) + rb * DM + h * 64;
    bf16x8 qf[4];
#pragma unroll
    for (int ds = 0; ds < 4; ++ds) { float f[8]; unpack8(*(const v4u*)(Qp + 16 * ds + 8 * hi), f);
        v4u w; w.x = pk2(f[0] * 0.125f, f[1] * 0.125f); w.y = pk2(f[2] * 0.125f, f[3] * 0.125f); w.z = pk2(f[4] * 0.125f, f[5] * 0.125f); w.w = pk2(f[6] * 0.125f, f[7] * 0.125f); qf[ds] = __builtin_bit_cast(bf16x8, w); }
    f32x16 O0 = (f32x16){}, O1 = (f32x16){}; float R = 0.f;
    const int trv = (4 * hi + q4) * VPITCH + 2 * (16 * g1 + 4 * p4);
    for (int k0 = q0; k0 >= 0; k0 -= 32) {
#pragma unroll
        for (int i = 0; i < 4; ++i) { const int id = lane + 64 * i, row = id >> 3, c8 = id & 7;
            *(LAS v4u*)(Kt + row * KPITCH + 16 * c8) = *(const v4u*)(Kg + (size_t)(k0 + row) * DM + 8 * c8);
            *(LAS v4u*)(Vt + row * VPITCH + 16 * c8) = *(const v4u*)(Vg + (size_t)(k0 + row) * DM + 8 * c8); }
        asm volatile("s_waitcnt lgkmcnt(0)" ::: "memory");
        f32x16 z = (f32x16){};
#pragma unroll
        for (int ds = 0; ds < 4; ++ds) z = __builtin_amdgcn_mfma_f32_32x32x16_bf16(ldf(Kt + r * KPITCH + 32 * ds + 16 * hi), qf[ds], z, 0, 0, 0);
        const bool diag = (k0 == q0);
        float y[16], suf[16], T[4], PT[4], off[4];
#pragma unroll
        for (int g = 0; g < 4; ++g) {
            float run = 0.f;
#pragma unroll
            for (int e = 3; e >= 0; --e) { const int rr = 4 * g + e; const bool valid = !diag || (8 * g + 4 * hi + e < r);
                const float yy = z[rr] * 1.4426950408889634f; y[rr] = yy;
                const float sp = fmaxf(yy, 0.f) + __builtin_amdgcn_logf(1.0f + __builtin_amdgcn_exp2f(-fabsf(yy)));
                run += valid ? -sp : 0.f; suf[rr] = run; }
            T[g] = run;
        }
#pragma unroll
        for (int g = 0; g < 4; ++g) PT[g] = __shfl_xor(T[g], 32);
        float above = 0.f;
#pragma unroll
        for (int g = 3; g >= 0; --g) { off[g] = above + (hi ? 0.f : PT[g]); above += T[g] + PT[g]; }
        f32x16 A;
#pragma unroll
        for (int g = 0; g < 4; ++g)
#pragma unroll
            for (int e = 0; e < 4; ++e) { const int rr = 4 * g + e; const bool valid = !diag || (8 * g + 4 * hi + e < r);
                A[rr] = valid ? __builtin_amdgcn_exp2f(y[rr] + (R + off[g] + suf[rr])) : 0.f; }
        R += above;
#pragma unroll
        for (int s = 0; s < 2; ++s) { const bf16x8 pb = pfrag(A, s);
            const bf16x8 v0 = cat8(trd(Vt + trv + (16 * s) * VPITCH), trd(Vt + trv + (16 * s + 8) * VPITCH));
            const bf16x8 v1 = cat8(trd(Vt + trv + (16 * s) * VPITCH + 64), trd(Vt + trv + (16 * s + 8) * VPITCH + 64));
            O0 = __builtin_amdgcn_mfma_f32_32x32x16_bf16(v0, pb, O0, 0, 0, 0); O1 = __builtin_amdgcn_mfma_f32_32x32x16_bf16(v1, pb, O1, 0, 0, 0); }
        if (__all(R < -58.0f)) break;
        asm volatile("s_waitcnt lgkmcnt(0)" ::: "memory");
    }
#pragma unroll
    for (int g = 0; g < 4; ++g) { *(v2u*)(Qp + 8 * g + 4 * hi) = (v2u){pk2(O0[4 * g], O0[4 * g + 1]), pk2(O0[4 * g + 2], O0[4 * g + 3])};
        *(v2u*)(Qp + 32 + 8 * g + 4 * hi) = (v2u){pk2(O1[4 * g], O1[4 * g + 1]), pk2(O1[4 * g + 2], O1[4 * g + 3])}; }
}

constexpr int M_K = 0, M_V = 2 * 64 * KPITCH, M_KM = M_V + 2 * 64 * VPITCH, M_CTL = M_KM + 4096;
__device__ __forceinline__ int moba_next(int pos, unsigned selany, int end) {
    int p = pos + 1;
    while (p >= 4 && p < end && !((selany >> ((p - 4) >> 2)) & 1u)) p = 4 + 4 * (((p - 4) >> 2) + 1);
    return p;
}
__device__ __forceinline__ void moba_mfma_unit(Frame& F, int b, int hd, int qb) {
    const int tid = F.tid, lane = F.lane, wid = F.wave, r = lane & 31, hi = lane >> 5, g1 = (lane >> 4) & 1, q4 = (lane & 15) >> 2, p4 = lane & 3;
    LAS unsigned char* L0 = F.lds + RING_OFF;
    LAS float* km = (LAS float*)(L0 + M_KM); volatile LAS unsigned* ctl = (volatile LAS unsigned*)(L0 + M_CTL);
    const int head = 8 + hd; const size_t rb = (size_t)b * SEQ; const int ql = 32 * wid + r;
    bf16* Qp = (bf16*)(F.ws + WS_Q) + (rb + 256 * qb + ql) * DM + head * 64;
    const bf16* Kg = (const bf16*)(F.ws + WS_K) + rb * DM + head * 64; const bf16* Vg = (const bf16*)(F.ws + WS_V) + rb * DM + head * 64;
    { const float* kmg = (const float*)(F.ws + WS_KMEAN) + (size_t)(b * 8 + hd) * 1024; km[tid] = kmg[tid]; km[tid + 512] = kmg[tid + 512]; }
    if (tid == 0) ctl[0] = 0u;
    bf16x8 qf[4]; float qv[4][8];
#pragma unroll
    for (int ds = 0; ds < 4; ++ds) { const v4u w = *(const v4u*)(Qp + 16 * ds + 8 * hi); qf[ds] = __builtin_bit_cast(bf16x8, w); unpack8(w, qv[ds]); }
    const int srow = tid >> 3, sc8 = tid & 7;
    const int sko = srow * KPITCH + 16 * sc8, svo = srow * VPITCH + 16 * sc8;
    const size_t sgo = (size_t)srow * DM + 8 * sc8;
    { const size_t t0 = (size_t)(4 * qb) * 64 * DM;
      *(LAS v4u*)(L0 + M_K + sko) = *(const v4u*)(Kg + t0 + sgo); *(LAS v4u*)(L0 + M_V + svo) = *(const v4u*)(Vg + t0 + sgo); }
    __syncthreads();
    const int own = qb; unsigned sel = 0u;
    if (own <= 3) sel = (1u << own) - 1u;
    else {
        float b1 = -3e38f, b2 = -3e38f, b3 = -3e38f; int i1 = 0, i2 = 0, i3 = 0;
#pragma unroll 1
        for (int n = 0; n < own; ++n) {
            float a = 0.f;
#pragma unroll
            for (int ds = 0; ds < 4; ++ds) { const f32x4 k0 = *(const LAS f32x4*)(km + n * 64 + 16 * ds + 8 * hi), k1 = *(const LAS f32x4*)(km + n * 64 + 16 * ds + 8 * hi + 4);
                a += qv[ds][0] * k0[0] + qv[ds][1] * k0[1] + qv[ds][2] * k0[2] + qv[ds][3] * k0[3] + qv[ds][4] * k1[0] + qv[ds][5] * k1[1] + qv[ds][6] * k1[2] + qv[ds][7] * k1[3]; }
            a += __shfl_xor(a, 32);
            if (a > b1) { b3 = b2; i3 = i2; b2 = b1; i2 = i1; b1 = a; i1 = n; }
            else if (a > b2) { b3 = b2; i3 = i2; b2 = a; i2 = n; }
            else if (a > b3) { b3 = a; i3 = n; }
        }
        sel = (1u << i1) | (1u << i2) | (1u << i3);
    }
    { unsigned so = sel;
#pragma unroll
      for (int o = 1; o < 64; o <<= 1) so |= (unsigned)__shfl_xor((int)so, o);
      if (lane == 0) atomicOr((unsigned*)(L0 + M_CTL), so); }
    __syncthreads();
    const unsigned selany = ctl[0];
    const int end = 4 + 4 * qb;
    f32x16 O0 = (f32x16){}, O1 = (f32x16){}; float m = -INFINITY, l = 0.f;
    const float CS = 0.125f * 1.4426950408889634f;
    const int trv = (4 * hi + q4) * VPITCH + 2 * (16 * g1 + 4 * p4);
    int pos = 0, cur = 0;
    while (pos < end) {
        const int nxt = moba_next(pos, selany, end);
        v4u kr, vr;
        if (nxt < end) { const int tn = (nxt < 4) ? 4 * qb + nxt : nxt - 4; const size_t to = (size_t)tn * 64 * DM; kr = *(const v4u*)(Kg + to + sgo); vr = *(const v4u*)(Vg + to + sgo); }
        const bool band = pos < 4;
        const bool skip = band && (64 * pos > 32 * wid + 31);
        if (!skip) {
            const LAS unsigned char* Kt = L0 + M_K + cur * (64 * KPITCH); const LAS unsigned char* Vt = L0 + M_V + cur * (64 * VPITCH);
            const float ci = band ? 0.f : (((sel >> ((pos - 4) >> 2)) & 1u) ? 0.f : -1e30f);
            f32x16 p0, p1;
#pragma unroll
            for (int i = 0; i < 16; ++i) { p0[i] = ci; p1[i] = ci; }
#pragma unroll
            for (int ds = 0; ds < 4; ++ds) { p0 = __builtin_amdgcn_mfma_f32_32x32x16_bf16(ldf(Kt + r * KPITCH + 32 * ds + 16 * hi), qf[ds], p0, 0, 0, 0);
                p1 = __builtin_amdgcn_mfma_f32_32x32x16_bf16(ldf(Kt + (32 + r) * KPITCH + 32 * ds + 16 * hi), qf[ds], p1, 0, 0, 0); }
            float rm = -INFINITY;
#pragma unroll
            for (int i = 0; i < 16; ++i) { const int kl = (i & 3) + 8 * (i >> 2) + 4 * hi;
                float s0 = p0[i] * CS, s1 = p1[i] * CS;
                if (band) { if (64 * pos + kl > ql) s0 = -INFINITY; if (64 * pos + 32 + kl > ql) s1 = -INFINITY; }
                p0[i] = s0; p1[i] = s1; rm = fmaxf(rm, fmaxf(s0, s1)); }
            rm = fmaxf(rm, __shfl_xor(rm, 32));
            const float mn = fmaxf(m, rm);
            if (__any(mn > m)) { const float al = __builtin_amdgcn_exp2f(m - mn); l *= al; O0 = O0 * al; O1 = O1 * al; }
            m = mn;
            float ls = 0.f;
#pragma unroll
            for (int i = 0; i < 16; ++i) { p0[i] = __builtin_amdgcn_exp2f(p0[i] - m); p1[i] = __builtin_amdgcn_exp2f(p1[i] - m); ls += p0[i] + p1[i]; }
            l += ls;
#pragma unroll
            for (int sub = 0; sub < 2; ++sub)
#pragma unroll
                for (int s = 0; s < 2; ++s) { const bf16x8 pb = pfrag(sub ? p1 : p0, s);
                    const LAS unsigned char* vb = Vt + trv + (32 * sub + 16 * s) * VPITCH;
                    const bf16x8 v0 = cat8(trd(vb), trd(vb + 8 * VPITCH)), v1 = cat8(trd(vb + 64), trd(vb + 8 * VPITCH + 64));
                    O0 = __builtin_amdgcn_mfma_f32_32x32x16_bf16(v0, pb, O0, 0, 0, 0); O1 = __builtin_amdgcn_mfma_f32_32x32x16_bf16(v1, pb, O1, 0, 0, 0); }
        }
        if (nxt < end) { *(LAS v4u*)(L0 + M_K + (cur ^ 1) * (64 * KPITCH) + sko) = kr; *(LAS v4u*)(L0 + M_V + (cur ^ 1) * (64 * VPITCH) + svo) = vr; }
        __syncthreads();
        cur ^= 1; pos = nxt;
    }
    l += __shfl_xor(l, 32);
    const float il = 1.0f / l;
#pragma unroll
    for (int g = 0; g < 4; ++g) { *(v2u*)(Qp + 8 * g + 4 * hi) = (v2u){pk2(O0[4 * g] * il, O0[4 * g + 1] * il), pk2(O0[4 * g + 2] * il, O0[4 * g + 3] * il)};
        *(v2u*)(Qp + 32 + 8 * g + 4 * hi) = (v2u){pk2(O1[4 * g] * il, O1[4 * g + 1] * il), pk2(O1[4 * g + 2] * il, O1[4 * g + 3] * il)}; }
    __syncthreads();
}
__device__ __forceinline__ void attn_phase(Frame& F) {
    for (int u = F.vcu; u < 256; u += F.G) { const int bhd = u >> 3, s = u & 7; moba_mfma_unit(F, bhd >> 3, bhd & 7, 15 - s); moba_mfma_unit(F, bhd >> 3, bhd & 7, s); }
    __syncthreads();
    const int gw = F.vcu * NWAVES + F.wave, NGW = F.G * NWAVES;
    for (int u = gw; u < NB * 8 * 128; u += NGW) sb_wave_unit(F, u >> 10, u & 7, (u >> 3) & 127);
}
}
#ifndef MK_N_LAUNCHES
#define MK_N_LAUNCHES 1
#endif
constexpr int NPH = 20;
struct Args { const float* in[13]; float* out; unsigned char* ws; int ph_lo, ph_hi, li, pad; };
__global__ void __launch_bounds__(NWAVES * 64, 2) mk_fwd(Args args) {
    extern __shared__ __attribute__((aligned(16))) unsigned char lds[];
    Frame F;
    F.lds = (LAS unsigned char*)lds; F.MISC = (volatile LAS unsigned*)(F.lds + MISC_OFF);
    F.tid = threadIdx.x; F.lane = F.tid & 63; F.wave = __builtin_amdgcn_readfirstlane(F.tid >> 6);
    F.G = gridDim.x; { const int bx = blockIdx.x; F.vcu = (F.G % 8 == 0) ? (bx % 8) * (F.G / 8) + bx / 8 : bx; }
    F.ws = args.ws; F.ctl = (gu32*)(args.ws + WS_CTL); F.out = args.out;
    F.x = args.in[0]; F.c = args.in[1]; F.ada_w = args.in[2]; F.ada_b = args.in[3]; F.ng = args.in[4]; F.wqkv = args.in[5]; F.wo = args.in[6];
    F.win = args.in[7]; F.gn = args.in[8]; F.rwo = args.in[9]; F.wgu = args.in[10]; F.wdn = args.in[11]; F.fng = args.in[12];
    for (int u = F.tid; u < (LDS_BYTES - LDSCTL_OFF) / 4; u += NWAVES * 64) ((LAS unsigned*)(F.lds + LDSCTL_OFF))[u] = 0u;
    __syncthreads();
    const int lo = args.ph_lo, hi = args.ph_hi;
    XcdBarrier bar; bar.bar = (unsigned*)(F.ctl + CW_BAR); bar.x = 0; bar.st = nullptr;
    if (hi - lo > 1) bar = xcd_barrier_post((unsigned*)(F.ctl + CW_BAR), F.MISC + 8);
#define IN(k) (lo <= (k) && (k) < hi)
#define SEAM(k) do { if (IN(k) && IN((k) + 1)) xcd_barrier(bar); } while (0)
    unsigned char* ws = args.ws;
    bf16* H = (bf16*)(ws + WS_H);
    const float* ada = (const float*)(ws + WS_ADA);

#ifndef NOP0
    if (IN(0)) { p0_prologue(F); } SEAM(0);
#else
    SEAM(0);
#endif
#ifndef NOP1
    if (IN(1)) { norm_mod_phase(F, F.x, F.ng + 0 * DM, 0, 0); } SEAM(1);
#else
    SEAM(1);
#endif
    if (IN(2)) {
        pg8::Gemm g{H, (const bf16*)(ws + WS_WQKV), MT, NQKV, DM}; pg8::StaticOrder S; S.init(MT, NQKV, F.G, (int)blockIdx.x);
        pg8::EpiBf16<0> E{(bf16*)(ws + WS_Q), DM, nullptr, DM, (size_t)(WS_K - WS_Q) / 2, 1.0f};
        pg8::gemm_phase<pg8::EpiBf16<0>, pg8::StaticOrder, true, true>(F.lds + RING_OFF, g, S, E);
    } SEAM(2);
#ifndef NOP3
    if (IN(3)) { rope_att_phase(F); } SEAM(3);
#else
    SEAM(3);
#endif
#ifndef NOP4
    if (IN(4)) { kmean_phase(F); } SEAM(4);
#else
    SEAM(4);
#endif
#ifndef NOP5
    if (IN(5)) { att::attn_phase(F); } SEAM(5);
#else
    SEAM(5);
#endif
    if (IN(6)) {
        pg8::Gemm g{(const bf16*)(ws + WS_Q), (const bf16*)(ws + WS_WO), MT, DM, DM}; pg8::StaticOrder S; S.init(MT, DM, F.G, (int)blockIdx.x);
        pg8::EpiRes E{F.x, F.out, ada + 2 * 1024};
        pg8::gemm_phase<pg8::EpiRes, pg8::StaticOrder, false, true>(F.lds + RING_OFF, g, S, E);
    } SEAM(6);
#ifndef NOP7
    if (IN(7)) { norm_mod_phase(F, F.out, F.ng + 1 * DM, 0, 3); } SEAM(7);
#else
    SEAM(7);
#endif
    if (IN(8)) {
        pg8::Gemm g{H, (const bf16*)(ws + WS_GU0), MT, NGU, DM}; pg8::StaticOrder S; S.init(MT, NGU, F.G, (int)blockIdx.x);
        pg8::EpiSwiglu E{(bf16*)(ws + WS_HMID0)};
        pg8::gemm_phase<pg8::EpiSwiglu, pg8::StaticOrder, true, true>(F.lds + RING_OFF, g, S, E);
    } SEAM(8);
    if (IN(9)) {
        pg8::Gemm g{(const bf16*)(ws + WS_HMID0), (const bf16*)(ws + WS_D0), MT, DM, DFF}; pg8::StaticOrder S; S.init(MT, DM, F.G, (int)blockIdx.x);
        pg8::EpiRes E{F.out, F.out, ada + 5 * 1024};
        pg8::gemm_phase<pg8::EpiRes, pg8::StaticOrder, false, true>(F.lds + RING_OFF, g, S, E);
    } SEAM(9);
#ifndef NOP10
    if (IN(10)) { norm_mod_phase(F, F.out, F.ng + 2 * DM, 1, 0); } SEAM(10);
#else
    SEAM(10);
#endif
    if (IN(11)) {
        pg8::Gemm g{H, (const bf16*)(ws + WS_WIN), MT, NRIN, DM}; pg8::StaticOrder S; S.init(MT, NRIN, F.G, (int)blockIdx.x);
        pg8::EpiWin E{(bf16*)(ws + WS_QR), (bf16*)(ws + WS_KR), (bf16*)(ws + WS_VR), (bf16*)(ws + WS_GR)};
        pg8::gemm_phase<pg8::EpiWin, pg8::StaticOrder, true, true>(F.lds + RING_OFF, g, S, E);
    } SEAM(11);
#ifndef NOP12
    if (IN(12)) { rope_ret_phase(F); convert_set_b(F); } SEAM(12);
#else
    SEAM(12);
#endif
#ifndef NOP13
    if (IN(13)) { ret::pass1_phase(F); xcd_barrier(bar); ret::pass2_phase(F); } SEAM(13);
#else
    SEAM(13);
#endif
#ifndef NOP14
    if (IN(14)) { gn_gate_phase(F); } SEAM(14);
#else
    SEAM(14);
#endif
    if (IN(15)) {
        pg8::Gemm g{(const bf16*)(ws + WS_VR), (const bf16*)(ws + WS_WRO), MT, DM, RV}; pg8::StaticOrder S; S.init(MT, DM, F.G, (int)blockIdx.x);
        pg8::EpiRes E{F.out, F.out, ada + 4 * 6144 + 2 * 1024};
        pg8::gemm_phase<pg8::EpiRes, pg8::StaticOrder, false, true>(F.lds + RING_OFF, g, S, E);
    } SEAM(15);
#ifndef NOP16
    if (IN(16)) { norm_mod_phase(F, F.out, F.ng + 3 * DM, 1, 3); } SEAM(16);
#else
    SEAM(16);
#endif
    if (IN(17)) {
        pg8::Gemm g{H, (const bf16*)(ws + WS_GU1), MT, NGU, DM}; pg8::StaticOrder S; S.init(MT, NGU, F.G, (int)blockIdx.x);
        pg8::EpiSwiglu E{(bf16*)(ws + WS_HMID1)};
        pg8::gemm_phase<pg8::EpiSwiglu, pg8::StaticOrder, true, true>(F.lds + RING_OFF, g, S, E);
    } SEAM(17);
    if (IN(18)) {
        pg8::Gemm g{(const bf16*)(ws + WS_HMID1), (const bf16*)(ws + WS_D1), MT, DM, DFF}; pg8::StaticOrder S; S.init(MT, DM, F.G, (int)blockIdx.x);
        pg8::EpiRes E{F.out, F.out, ada + 4 * 6144 + 5 * 1024};
        pg8::gemm_phase<pg8::EpiRes, pg8::StaticOrder, false, true>(F.lds + RING_OFF, g, S, E);
    } SEAM(18);
#ifndef NOP19
    if (IN(19)) { final_norm_phase(F); }
#else

#endif
#undef IN
#undef SEAM
}

extern "C" void kernel_launch(void* const* d_in, const int* in_sizes, int n_in, void* d_out, int out_size, void* d_ws, size_t ws_size, hipStream_t stream) {
    static int grid = 0;
    if (grid == 0) {
        if (n_in != 13 || out_size != MT * DM || ws_size < WS_END) { fprintf(stderr, "kernel_launch: unexpected shapes (n_in %d out %d ws %zu)\n", n_in, out_size, ws_size); grid = -1; return; }
        int dev = 0, cus = 0;
        if (hipGetDevice(&dev) != hipSuccess || hipDeviceGetAttribute(&cus, hipDeviceAttributeMultiprocessorCount, dev) != hipSuccess) { grid = -1; return; }
        if (hipFuncSetAttribute((const void*)mk_fwd, hipFuncAttributeMaxDynamicSharedMemorySize, LDS_BYTES) != hipSuccess) { fprintf(stderr, "kernel_launch: hipFuncSetAttribute failed\n"); grid = -1; return; }
        int per_cu = 0;
        if (hipOccupancyMaxActiveBlocksPerMultiprocessor(&per_cu, (const void*)mk_fwd, NWAVES * 64, LDS_BYTES) != hipSuccess || per_cu < 1) fprintf(stderr, "kernel_launch: occupancy query says %d\n", per_cu);
        (void)hipGetLastError();
        grid = cus;
    }
    if (grid < 0) return;
    if (hipMemsetAsync((char*)d_ws + WS_CTL, 0, CTL_ZERO_BYTES, stream) != hipSuccess) return;
    Args a{};
    for (int i = 0; i < 13; ++i) a.in[i] = (const float*)d_in[i];
    a.out = (float*)d_out; a.ws = (unsigned char*)d_ws;
    const int NL = MK_N_LAUNCHES;
    for (int li = 0; li < NL; ++li) {
        a.ph_lo = (NL == 1) ? 0 : li; a.ph_hi = (NL == 1) ? NPH : li + 1; a.li = li;
        hipLaunchKernelGGL(mk_fwd, dim3(grid), dim3(NWAVES * 64), LDS_BYTES, stream, a);
    }
}
```
